# Optimizing an MI355X kernel written in HIP

```python
import math
import jax, jax.numpy as jnp
from jax import lax
import numpy as np

D_MODEL = 1024
BATCH = 8
SEQ = 8192
DEPTH = 1

D_MIX = D_MODEL
D_ATTN = D_MIX // 2
D_SSM = D_MIX - D_ATTN
N_HEADS = 4
QK_NOPE = 128
QK_ROPE = 64
V_HEAD = D_ATTN // N_HEADS
Q_LORA = 384
KV_LORA = 256
ROPE_THETA = 10000.0
Q_BLOCK = 128
MAX_POS_OFFSET = 4096
SSM_GROUP = 16
N_SSM_GROUPS = D_SSM // SSM_GROUP
SSM_STATE = 64
DT_MIN = 1e-3
DT_MAX = 1e-1
SSM_C_STD = 0.5
D_FF = 2816
CONV_W = 3
EPS = 1e-6
IN_COLS = Q_LORA + KV_LORA + QK_ROPE + D_SSM
OFF_KV = Q_LORA
OFF_KR = Q_LORA + KV_LORA
OFF_U = Q_LORA + KV_LORA + QK_ROPE

kernel_name = 'hymba_mla_s5_convglu_adaln'


def _rmsnorm(x, g):
    xf = x.astype(jnp.float32)
    xf = xf * lax.rsqrt(jnp.mean(xf * xf, axis=-1, keepdims=True) + EPS)
    return (xf * g.astype(jnp.float32)).astype(x.dtype)


def _modulate(h, shift, scale):
    return h * (1.0 + scale[:, None, :]) + shift[:, None, :]


def _rope_tables(positions):
    inv_freq = ROPE_THETA ** (-jnp.arange(0, QK_ROPE, 2, dtype=jnp.float32) / QK_ROPE)
    ang = positions.astype(jnp.float32)[..., None] * inv_freq
    return jnp.cos(ang), jnp.sin(ang)


def _apply_rope(x, cos, sin):
    xf = x.astype(jnp.float32)
    x1, x2 = xf[..., :QK_ROPE // 2], xf[..., QK_ROPE // 2:]
    return jnp.concatenate([x1 * cos - x2 * sin, x1 * sin + x2 * cos], axis=-1).astype(x.dtype)


def _mla(zq, zkv, zkr, positions, q_norm_g, w_uq, kv_norm_g, w_ukv):
    bsz, seq, _ = zq.shape
    cos, sin = _rope_tables(positions)
    q = (_rmsnorm(zq, q_norm_g) @ w_uq).reshape(bsz, seq, N_HEADS, QK_NOPE + QK_ROPE)
    q_nope = q[..., :QK_NOPE]
    q_rope = _apply_rope(q[..., QK_NOPE:], cos[:, :, None, :], sin[:, :, None, :])
    kv = (_rmsnorm(zkv, kv_norm_g) @ w_ukv).reshape(bsz, seq, N_HEADS, QK_NOPE + V_HEAD)
    k_nope, v = kv[..., :QK_NOPE], kv[..., QK_NOPE:]
    k_rope = _apply_rope(zkr, cos, sin)
    n_blk = seq // Q_BLOCK
    qn_blk = q_nope.reshape(bsz, n_blk, Q_BLOCK, N_HEADS, QK_NOPE).transpose(1, 0, 2, 3, 4)
    qr_blk = q_rope.reshape(bsz, n_blk, Q_BLOCK, N_HEADS, QK_ROPE).transpose(1, 0, 2, 3, 4)
    key_idx = jnp.arange(seq)
    scale = (QK_NOPE + QK_ROPE) ** -0.5

    def one_block(args):
        qn, qr, blk = args
        s = (jnp.einsum('bqhd,bkhd->bhqk', qn, k_nope)
             + jnp.einsum('bqhr,bkr->bhqk', qr, k_rope)).astype(jnp.float32) * scale
        q_idx = blk * Q_BLOCK + jnp.arange(Q_BLOCK)
        s = jnp.where(key_idx[None, :] <= q_idx[:, None], s, -1e30)
        p = jax.nn.softmax(s, axis=-1).astype(v.dtype)
        return jnp.einsum('bhqk,bkhd->bqhd', p, v)

    o = lax.map(one_block, (qn_blk, qr_blk, jnp.arange(n_blk)))
    return o.transpose(1, 0, 2, 3, 4).reshape(bsz, seq, N_HEADS * V_HEAD)


def _ssm_combine(e1, e2):
    a1r, a1i, b1r, b1i = e1
    a2r, a2i, b2r, b2i = e2
    return (a2r * a1r - a2i * a1i,
            a2r * a1i + a2i * a1r,
            a2r * b1r - a2i * b1i + b2r,
            a2r * b1i + a2i * b1r + b2i)


def _s5(zu, lam_re, lam_im, log_dt, b_re, b_im, c_re, c_im, d_skip, w_glu, b_glu):
    bsz, seq, _ = zu.shape
    f32 = jnp.float32
    uf = zu.astype(f32).reshape(bsz, seq, N_SSM_GROUPS, SSM_GROUP)
    lr = jnp.minimum(lam_re.astype(f32), -1e-4)
    li = lam_im.astype(f32)
    dt = jnp.exp(log_dt.astype(f32))[:, None]
    mag = jnp.exp(lr * dt)
    ab_re = mag * jnp.cos(li * dt)
    ab_im = mag * jnp.sin(li * dt)
    den = lr * lr + li * li
    nr, ni = ab_re - 1.0, ab_im
    z_re = ((nr * lr + ni * li) / den)[..., None]
    z_im = ((ni * lr - nr * li) / den)[..., None]
    br, bi = b_re.astype(f32), b_im.astype(f32)
    bb_re = z_re * br - z_im * bi
    bb_im = z_re * bi + z_im * br
    bu_re = jnp.einsum('bsgh,gph->sbgp', uf, bb_re)
    bu_im = jnp.einsum('bsgh,gph->sbgp', uf, bb_im)
    a_re = jnp.broadcast_to(ab_re[None, None], (seq, 1, N_SSM_GROUPS, SSM_STATE))
    a_im = jnp.broadcast_to(ab_im[None, None], (seq, 1, N_SSM_GROUPS, SSM_STATE))
    _, _, xr, xi = lax.associative_scan(_ssm_combine, (a_re, a_im, bu_re, bu_im), axis=0)
    y = (jnp.einsum('sbgp,ghp->bsgh', xr, c_re.astype(f32))
         - jnp.einsum('sbgp,ghp->bsgh', xi, c_im.astype(f32))
         + d_skip.astype(f32) * uf)
    y = jax.nn.gelu(y.reshape(bsz, seq, D_SSM))
    gl = y @ w_glu.astype(f32) + b_glu.astype(f32)
    out = gl[..., :D_SSM] * jax.nn.sigmoid(gl[..., D_SSM:])
    return out.astype(zu.dtype)


def _causal_dwconv(x, w, b):
    seq = x.shape[1]
    xp = jnp.pad(x, ((0, 0), (CONV_W - 1, 0), (0, 0)))
    y = b
    for k in range(CONV_W):
        y = y + w[k] * xp[:, k:k + seq, :]
    return y


def setup_inputs(seed: int = 0) -> dict:
    key = jax.random.key(seed)
    ks = jax.random.split(key, 32)
    f32 = jnp.float32
    L, G, P, H = DEPTH, N_SSM_GROUPS, SSM_STATE, SSM_GROUP

    def nrm(k, shape, std):
        return jax.random.normal(k, shape, f32) * std

    x = nrm(ks[0], (BATCH, SEQ, D_MODEL), 1.0)
    c = nrm(ks[1], (BATCH, D_MODEL), 1.0)
    offsets = jax.random.randint(ks[2], (BATCH, 1), 0, MAX_POS_OFFSET, dtype=jnp.int32)
    positions = offsets + jnp.arange(SEQ, dtype=jnp.int32)[None, :]
    return {
        'x': x,
        'c': c,
        'positions': positions,
        'w_mod': nrm(ks[3], (L, D_MODEL, 6 * D_MODEL), D_MODEL ** -0.5),
        'b_mod': nrm(ks[4], (L, 6 * D_MODEL), 0.02),
        'ln1_g': 1.0 + nrm(ks[5], (L, D_MODEL), 0.02),
        'w_in': nrm(ks[6], (L, D_MODEL, IN_COLS), D_MODEL ** -0.5),
        'q_norm_g': 1.0 + nrm(ks[7], (L, Q_LORA), 0.02),
        'w_uq': nrm(ks[8], (L, Q_LORA, N_HEADS * (QK_NOPE + QK_ROPE)), Q_LORA ** -0.5),
        'kv_norm_g': 1.0 + nrm(ks[9], (L, KV_LORA), 0.02),
        'w_ukv': nrm(ks[10], (L, KV_LORA, N_HEADS * (QK_NOPE + V_HEAD)), KV_LORA ** -0.5),
        'ssm_lam_re': -0.5 + nrm(ks[11], (L, G, P), 0.01),
        'ssm_lam_im': jnp.tile(math.pi * jnp.arange(P, dtype=f32), (L, G, 1)),
        'ssm_log_dt': jax.random.uniform(ks[12], (L, G), f32, math.log(DT_MIN), math.log(DT_MAX)),
        'ssm_b_re': nrm(ks[13], (L, G, P, H), (2 * H) ** -0.5),
        'ssm_b_im': nrm(ks[14], (L, G, P, H), (2 * H) ** -0.5),
        'ssm_c_re': nrm(ks[15], (L, G, H, P), SSM_C_STD),
        'ssm_c_im': nrm(ks[16], (L, G, H, P), SSM_C_STD),
        'ssm_d': nrm(ks[17], (L, G, H), 1.0),
        'w_glu': nrm(ks[18], (L, D_SSM, 2 * D_SSM), D_SSM ** -0.5),
        'b_glu': nrm(ks[19], (L, 2 * D_SSM), 0.02),
        'attn_out_g': 1.0 + nrm(ks[20], (L, D_ATTN), 0.02),
        'ssm_out_g': 1.0 + nrm(ks[21], (L, D_SSM), 0.02),
        'w_out': nrm(ks[22], (L, D_MIX, D_MODEL), D_MIX ** -0.5),
        'ln2_g': 1.0 + nrm(ks[23], (L, D_MODEL), 0.02),
        'w_up': nrm(ks[24], (L, D_MODEL, 2 * D_FF), D_MODEL ** -0.5),
        'conv_w': nrm(ks[25], (L, CONV_W, D_FF), CONV_W ** -0.5),
        'conv_b': nrm(ks[26], (L, D_FF), 0.02),
        'w_down': nrm(ks[27], (L, D_FF, D_MODEL), D_FF ** -0.5),
        'final_g': 1.0 + nrm(ks[28], (D_MODEL,), 0.02),
    }


def reference(x, c, positions, w_mod, b_mod, ln1_g, w_in, q_norm_g, w_uq, kv_norm_g, w_ukv,
              ssm_lam_re, ssm_lam_im, ssm_log_dt, ssm_b_re, ssm_b_im, ssm_c_re, ssm_c_im,
              ssm_d, w_glu, b_glu, attn_out_g, ssm_out_g, w_out, ln2_g, w_up, conv_w, conv_b,
              w_down, final_g):
    cond = jax.nn.silu(c)
    for l in range(DEPTH):
        mod = cond @ w_mod[l] + b_mod[l]
        sh_a, sc_a, g_a, sh_f, sc_f, g_f = jnp.split(mod, 6, axis=-1)
        h = _modulate(_rmsnorm(x, ln1_g[l]), sh_a, sc_a)
        z = h @ w_in[l]
        a = _mla(z[..., :OFF_KV], z[..., OFF_KV:OFF_KR], z[..., OFF_KR:OFF_U], positions,
                 q_norm_g[l], w_uq[l], kv_norm_g[l], w_ukv[l])
        s = _s5(z[..., OFF_U:], ssm_lam_re[l], ssm_lam_im[l], ssm_log_dt[l], ssm_b_re[l],
                ssm_b_im[l], ssm_c_re[l], ssm_c_im[l], ssm_d[l], w_glu[l], b_glu[l])
        m = jnp.concatenate([_rmsnorm(a, attn_out_g[l]), _rmsnorm(s, ssm_out_g[l])], axis=-1) @ w_out[l]
        x = x + g_a[:, None, :] * m
        h = _modulate(_rmsnorm(x, ln2_g[l]), sh_f, sc_f)
        up = h @ w_up[l]
        gate_in, val = up[..., :D_FF], up[..., D_FF:]
        f = (jax.nn.gelu(_causal_dwconv(gate_in, conv_w[l], conv_b[l])) * val) @ w_down[l]
        x = x + g_f[:, None, :] * f
    return _rmsnorm(x, final_g)
```

```cpp
#include <hip/hip_runtime.h>
#include <hip/hip_cooperative_groups.h>
#include <cstdio>
#include <cstdint>
namespace cg = cooperative_groups;
#ifndef PHM
#define PHM 255
#endif
#ifndef ATT_SGB
#define ATT_SGB 0
#endif
#ifndef DBL
#define DBL 0
#endif
#define REP(bit) for (int rep_ = 0; rep_ < ((DBL & (bit)) ? 2 : 1); ++rep_)
#ifndef P3SEL
#define P3SEL 7
#endif
#ifndef P4SEL
#define P4SEL 3
#endif

#define LAS __attribute__((address_space(3)))
typedef unsigned short bf16_t;
typedef short bf16x8 __attribute__((ext_vector_type(8)));
typedef float f32x2 __attribute__((ext_vector_type(2)));
typedef float f32x4 __attribute__((ext_vector_type(4)));
typedef float f32x16 __attribute__((ext_vector_type(16)));
typedef unsigned u32x2 __attribute__((ext_vector_type(2)));
typedef unsigned u32x4 __attribute__((ext_vector_type(4)));
typedef __bf16 bf16x2_t __attribute__((ext_vector_type(2)));

constexpr int NB = 8, SEQ = 8192, DM = 1024, NT = NB * SEQ;
constexpr int NIN = 1216, NINP = 1280;
constexpr int DFF = 2816;
constexpr float EPS = 1e-6f;
constexpr float QSCALE = 0.07216878364870322f * 1.4426950408889634f;

constexpr size_t MiB = 1u << 20;
constexpr size_t WS_WIN = 0 * MiB;
constexpr size_t WS_WUQ = 3 * MiB;
constexpr size_t WS_WUKV = 4 * MiB;
constexpr size_t WS_WGLU = 5 * MiB;
constexpr size_t WS_WOUT = 6 * MiB;
constexpr size_t WS_WUP = 8 * MiB;
constexpr size_t WS_WDOWN = 19 * MiB;
constexpr size_t WS_WS5S = 25 * MiB;
constexpr size_t WS_WS5T = 29 * MiB;
constexpr size_t WS_MOD = 35 * MiB;
constexpr size_t WS_BAR = 35 * MiB + 768 * 1024;
constexpr size_t WS_CS = 36 * MiB;
constexpr size_t WS_SSQ1 = 52 * MiB;
constexpr size_t WS_ASSQ = 60 * MiB;
constexpr size_t WS_SSQ2 = 61 * MiB;
constexpr size_t WS_SSQ3 = 65 * MiB;
constexpr size_t WS_SSQ4 = 73 * MiB;
constexpr size_t WS_HALO = 81 * MiB;
constexpr size_t WS_FIX = 92 * MiB;
constexpr size_t WS_YSSM = 114 * MiB;
constexpr size_t WS_AS = 178 * MiB;
constexpr size_t WS_R1 = 306 * MiB;
constexpr size_t WS_H1 = WS_R1;
constexpr size_t WS_Z = WS_R1 + 128 * MiB;
constexpr size_t WS_UX = WS_R1 + 208 * MiB;
constexpr size_t WS_SB = WS_R1 + 304 * MiB;
constexpr size_t WS_Q = WS_R1 + 368 * MiB;
constexpr size_t WS_KN = WS_R1 + 464 * MiB;
constexpr size_t WS_VT = WS_R1 + 528 * MiB;
constexpr size_t WS_KR = WS_R1 + 592 * MiB;
constexpr size_t WS_RST = WS_R1 + 592 * MiB;
constexpr size_t WS_H2 = WS_R1;
constexpr size_t WS_ACT = WS_R1 + 128 * MiB;
constexpr size_t WS_END = WS_R1 + 600 * MiB;

__device__ __forceinline__ unsigned pk2(float lo, float hi) { f32x2 v = {lo, hi}; bf16x2_t b = __builtin_convertvector(v, bf16x2_t); return __builtin_bit_cast(unsigned, b); }
__device__ __forceinline__ u32x4 pack8(f32x4 a, f32x4 b) { u32x4 w; w.x = pk2(a[0], a[1]); w.y = pk2(a[2], a[3]); w.z = pk2(b[0], b[1]); w.w = pk2(b[2], b[3]); return w; }
__device__ __forceinline__ float bflo(unsigned w) { return __uint_as_float(w << 16); }
__device__ __forceinline__ float bfhi(unsigned w) { return __uint_as_float(w & 0xffff0000u); }
__device__ __forceinline__ float sum4(f32x4 v) { return (v[0] + v[1]) + (v[2] + v[3]); }
__device__ __forceinline__ float dot4(f32x4 v) { return (v[0] * v[0] + v[1] * v[1]) + (v[2] * v[2] + v[3] * v[3]); }
__device__ __forceinline__ float red_fq(float v) { v += __shfl_xor(v, 16); v += __shfl_xor(v, 32); return v; }
__device__ __forceinline__ float wave_sum(float v) {
#pragma unroll
    for (int o = 1; o < 64; o <<= 1) v += __shfl_xor(v, o);
    return v;
}
__device__ __forceinline__ float gelu_t(float x) {
    const float u = 0.7978845608028654f * (x + 0.044715f * x * x * x);
    const float e = __builtin_amdgcn_exp2f(-2.885390081777927f * u);
    return x * __builtin_amdgcn_rcpf(1.f + e);
}
__device__ __forceinline__ float sigmoid_f(float g) { return __builtin_amdgcn_rcpf(1.f + __builtin_amdgcn_exp2f(-1.4426950408889634f * g)); }
__device__ __forceinline__ void sincos_d(double ang, float& s, float& c) {
    double rv = ang * 0.15915494309189535; rv -= rint(rv); const float r = (float)(rv * 6.283185307179586);
    s = sinf(r); c = cosf(r);
}

namespace pg8 {
constexpr int BM = 256, BK = 64, HALF = 128, HTB = HALF * BK * 2, STAGE_BYTES = 8 * HTB, NXCD = 8, WGM = 4;
__host__ __device__ __forceinline__ int lds_byte(int r, int c) { const int st = (r >> 4) * 2 + (c >> 5), rr = r & 15, cc = c & 31, ob = rr * 64 + cc * 2; return st * 1024 + (ob ^ (((ob >> 9) & 1) << 5)); }
__host__ __device__ __forceinline__ void stage_rc(int b, int& R, int& C) { const int st = b / 1024, sb = b % 1024, swz = sb ^ (((sb >> 9) & 1) << 5); R = (st >> 1) * 16 + swz / 64; C = (st & 1) * 32 + (swz % 64) / 2; }
__host__ __device__ __forceinline__ int perm32(int rho) { const int n = rho >> 4, i = rho & 15; return 8 * (i >> 2) + 4 * n + (i & 3); }

struct Unit { int pm, pn, g; size_t aoff, boff; };
struct Gemm { const bf16_t* A; const bf16_t* Bt; int K; int lda; };

struct StaticOrder {
    int nM, nN, nwg, G, c; size_t tA, tB;
    __device__ void init(int nM_, int nN_, int G_, int c_, size_t tA_, size_t tB_) { nM = nM_; nN = nN_; nwg = nM * nN; G = G_; c = c_; tA = tA_; tB = tB_; }
    __device__ bool next(int i, Unit& u) const {
        const long L = (long)i * G + c; if (L >= nwg) return false;
        int wgid = (int)L; { const int q = nwg / NXCD, r = nwg % NXCD, xcd = wgid % NXCD, off = wgid / NXCD; wgid = (xcd < r ? xcd * (q + 1) : r * (q + 1) + (xcd - r) * q) + off; }
        const int nig = WGM * nN, gid = wgid / nig, fm = gid * WGM, gsz = (nM - fm) < WGM ? (nM - fm) : WGM;
        u.pm = fm + ((wgid % nig) % gsz); u.pn = (wgid % nig) / gsz; u.g = 0; u.aoff = (size_t)u.pm * tA; u.boff = (size_t)u.pn * tB; return true;
    }
};
struct GroupOrder {
    int G, c; size_t gA, gB, tA;
    __device__ bool next(int i, Unit& u) const { const long L = (long)i * G + c; if (L >= 512) return false; u.g = (int)(L >> 4); u.pm = (int)(L & 15); u.pn = 0; u.aoff = (size_t)u.g * gA + (size_t)u.pm * tA; u.boff = (size_t)u.g * gB; return true; }
};
struct PanelOrder {
    int pm, nN; size_t tA, tB;
    __device__ bool next(int i, Unit& u) const { if (i >= nN) return false; u.pm = pm; u.pn = i; u.g = 0; u.aoff = (size_t)pm * tA; u.boff = (size_t)i * tB; return true; }
};
struct BGOrder {
    int b, g; size_t gA, gB, tA;
    __device__ bool next(int i, Unit& u) const { if (i >= 2) return false; u.g = g; u.pm = 2 * b + i; u.pn = 0; u.aoff = (size_t)g * gA + (size_t)u.pm * tA; u.boff = (size_t)g * gB; return true; }
};

template <class Epi, class Sched>
__device__ __forceinline__ void gemm_phase(LAS unsigned char* lds, const Gemm g, const Sched& S, const Epi& E) {
    int tid_ = threadIdx.x; asm volatile("" : "+v"(tid_));
    const int tid = tid_, wid = __builtin_amdgcn_readfirstlane(tid >> 6), lane = tid & 63, wr = wid >> 2, wc = wid & 3, fr = lane & 15, fq = lane >> 4;
    int K_ = g.K; asm volatile("" : "+s"(K_));
    const int K = K_, nt = K / BK, lda = g.lda;
    unsigned voffA[2], voffB[2];
#pragma unroll
    for (int i = 0; i < 2; ++i) { int R, C; stage_rc(tid * 16 + i * 8192, R, C); const int Rb = Epi::PERM ? ((R & ~31) + perm32(R & 31)) : R;
        const int Ra = Epi::ROWPERM ? (8 * (16 * (R >> 6) + (R & 15)) + ((R >> 4) & 3)) : R;
        voffA[i] = (unsigned)(Ra * lda + C) * 2u; voffB[i] = (unsigned)(Rb * K + C) * 2u; }
    const size_t kstep = (size_t)(BK * 2);
    const size_t hstepA = (size_t)(Epi::ROWPERM ? 4 : HALF) * lda * 2;
    const size_t hstepB = (size_t)HALF * K * 2;
    const unsigned ldsw = (unsigned)wid * 1024u;
    const int aoff = lds_byte(wr * 64 + fr, fq * 8), boff = lds_byte(wc * 32 + fr, fq * 8);
#define PG8_SA(b, h) (((b) * 2 + (h)) * HTB)
#define PG8_SB(b, h) ((4 + (b) * 2 + (h)) * HTB)
#define PG8_STAGE(bufoff, gbase, voff) do { _Pragma("unroll") for (int _i = 0; _i < 2; ++_i) \
        __builtin_amdgcn_global_load_lds((const unsigned*)((const char*)(gbase) + (voff)[_i]), (LAS unsigned*)(lds + (bufoff) + ldsw + _i * 8192), 16, 0, 0); } while (0)
#define PG8_LDA(dst, b, h) do { _Pragma("unroll") for (int m = 0; m < 4; ++m) _Pragma("unroll") for (int k = 0; k < 2; ++k) dst[m][k] = *(const LAS bf16x8*)(lds + PG8_SA(b, h) + aoff + m * 2048 + k * 1024); } while (0)
#define PG8_LDB(dst, b, h) do { _Pragma("unroll") for (int n = 0; n < 2; ++n) _Pragma("unroll") for (int k = 0; k < 2; ++k) dst[n][k] = *(const LAS bf16x8*)(lds + PG8_SB(b, h) + boff + n * 2048 + k * 1024); } while (0)
#define PG8_MMA(ai, bj, At, Bt) do { __builtin_amdgcn_s_setprio(1); _Pragma("unroll") for (int m = 0; m < 4; ++m) _Pragma("unroll") for (int n = 0; n < 2; ++n) _Pragma("unroll") for (int k = 0; k < 2; ++k) \
        acc[ai][bj][m][n] = __builtin_amdgcn_mfma_f32_16x16x32_bf16(Bt[n][k], At[m][k], acc[ai][bj][m][n], 0, 0, 0); __builtin_amdgcn_s_setprio(0); } while (0)
#define PG8_WAIT_V(n) asm volatile("s_waitcnt vmcnt(" #n ")" ::: "memory")
#define PG8_WAIT_L(n) asm volatile("s_waitcnt lgkmcnt(" #n ")" ::: "memory")
#define PG8_BAR __builtin_amdgcn_s_barrier()
#define PG8_SCHED __builtin_amdgcn_sched_barrier(0)
    Unit cur, nxt; int ui = 0;
    if (!S.next(0, cur)) return;
    f32x4 acc[2][2][4][2];
#pragma unroll
    for (int a = 0; a < 2; ++a)
#pragma unroll
        for (int b = 0; b < 2; ++b)
#pragma unroll
            for (int m = 0; m < 4; ++m)
#pragma unroll
                for (int n = 0; n < 2; ++n) acc[a][b][m][n] = (f32x4){0.f, 0.f, 0.f, 0.f};
    bf16x8 At[4][2], B0[2][2], B1[2][2];
    const char* cA = (const char*)g.A + cur.aoff; const char* cB = (const char*)g.Bt + cur.boff;
    PG8_STAGE(PG8_SB(0, 0), cB, voffB); PG8_STAGE(PG8_SB(0, 1), cB + hstepB, voffB); PG8_STAGE(PG8_SA(0, 0), cA, voffA); PG8_STAGE(PG8_SA(0, 1), cA + hstepA, voffA);
    if (wr == 1) PG8_BAR;
    PG8_WAIT_V(2); PG8_BAR;
    PG8_STAGE(PG8_SB(1, 0), cB + kstep, voffB); PG8_STAGE(PG8_SA(1, 0), cA + kstep, voffA); PG8_STAGE(PG8_SB(1, 1), cB + hstepB + kstep, voffB);
    PG8_WAIT_V(6); PG8_BAR;
    for (;;) {
        const bool has_next = S.next(ui + 1, nxt);
        const char* nA = has_next ? (const char*)g.A + nxt.aoff : cA; const char* nB = has_next ? (const char*)g.Bt + nxt.boff : cB;
#pragma unroll 1
        for (int t = 0; t < nt; t += 2) {
            const bool last = (t == nt - 2);
            const char* a1 = cA + (size_t)(t + 1) * kstep;
            const char* a2 = last ? nA : cA + (size_t)(t + 2) * kstep; const char* b2 = last ? nB : cB + (size_t)(t + 2) * kstep;
            const char* a3 = a2 + kstep; const char* b3 = b2 + kstep;
            if constexpr (Epi::MIDK) { if (t == 8) E.mid(acc, cur, wr, wc, fr, fq); }
            PG8_LDB(B0, 0, 0); PG8_LDB(B1, 0, 1); PG8_SCHED; PG8_LDA(At, 0, 0); PG8_STAGE(PG8_SA(1, 1), a1 + hstepA, voffA);
            PG8_WAIT_V(8); PG8_WAIT_L(0); PG8_BAR; PG8_MMA(0, 0, At, B0); PG8_MMA(0, 1, At, B1); PG8_BAR; PG8_SCHED;
            PG8_LDA(At, 0, 1); PG8_STAGE(PG8_SB(0, 0), b2, voffB); PG8_STAGE(PG8_SB(0, 1), b2 + hstepB, voffB); PG8_STAGE(PG8_SA(0, 0), a2, voffA);
            PG8_WAIT_V(8); PG8_WAIT_L(0); PG8_BAR; PG8_MMA(1, 0, At, B0); PG8_MMA(1, 1, At, B1); PG8_BAR; PG8_SCHED;
            PG8_LDB(B0, 1, 0); PG8_LDB(B1, 1, 1); PG8_SCHED; PG8_LDA(At, 1, 0); PG8_STAGE(PG8_SA(0, 1), a2 + hstepA, voffA);
            PG8_WAIT_V(8); PG8_WAIT_L(0); PG8_BAR; PG8_MMA(0, 0, At, B0); PG8_MMA(0, 1, At, B1); PG8_BAR; PG8_SCHED;
            PG8_LDA(At, 1, 1); PG8_STAGE(PG8_SB(1, 0), b3, voffB); PG8_STAGE(PG8_SB(1, 1), b3 + hstepB, voffB); PG8_STAGE(PG8_SA(1, 0), a3, voffA);
            PG8_WAIT_V(8); PG8_WAIT_L(0); PG8_BAR; PG8_MMA(1, 0, At, B0); PG8_MMA(1, 1, At, B1); PG8_BAR; PG8_SCHED;
        }
        if (wr == 0) PG8_BAR;
        E(acc, cur, wr, wc, fr, fq);
        if (!has_next) break;
#pragma unroll
        for (int a = 0; a < 2; ++a)
#pragma unroll
            for (int b = 0; b < 2; ++b)
#pragma unroll
                for (int m = 0; m < 4; ++m)
#pragma unroll
                    for (int n = 0; n < 2; ++n) acc[a][b][m][n] = (f32x4){0.f, 0.f, 0.f, 0.f};
        cur = nxt; cA = nA; cB = nB; ++ui;
        if (wr == 1) PG8_BAR;
    }
    PG8_WAIT_V(0);
    PG8_BAR;
#undef PG8_SA
#undef PG8_SB
#undef PG8_STAGE
#undef PG8_LDA
#undef PG8_LDB
#undef PG8_MMA
#undef PG8_WAIT_V
#undef PG8_WAIT_L
#undef PG8_BAR
#undef PG8_SCHED
}
}
using pg8::Unit;
typedef f32x4 Acc[2][2][4][2];

struct Epi1 {
    static constexpr bool PERM = true, ROWPERM = false, MIDK = false;
    bf16_t* Z; bf16_t* KR; bf16_t* UX; float* SSQ; const f32x2* CS;
    __device__ __forceinline__ void operator()(const Acc& acc, const Unit& u, int wr, int wc, int fr, int fq) const {
        int rb = u.pm * 256 + wr * 64 + fr;
#pragma unroll
        for (int bj = 0; bj < 2; ++bj) {
            const int gc = u.pn * 256 + bj * 128 + wc * 32, c0 = gc + 8 * fq;
            if (gc >= NIN) continue;
#pragma unroll
            for (int ai = 0; ai < 2; ++ai)
#pragma unroll
                for (int m = 0; m < 4; ++m) {
                    asm volatile("" : "+v"(rb)); const int row = rb + ai * 128 + m * 16;
                    const f32x4 v0 = acc[ai][bj][m][0], v1 = acc[ai][bj][m][1];
                    if (gc < 640) {
                        *(u32x4*)(Z + (size_t)row * 640 + c0) = pack8(v0, v1);
                        const float ss = red_fq(dot4(v0) + dot4(v1));
                        if (fq == 0) SSQ[(size_t)row * 32 + (gc >> 5)] = ss;
                    } else if (gc < 704) {
                        const f32x2* cs = CS + (size_t)row * 32 + ((c0 - 640) >> 1);
                        const f32x2 t0 = cs[0], t1 = cs[1], t2 = cs[2], t3 = cs[3];
                        f32x4 o0, o1;
                        o0[0] = v0[0] * t0.x - v0[1] * t0.y; o0[1] = v0[0] * t0.y + v0[1] * t0.x;
                        o0[2] = v0[2] * t1.x - v0[3] * t1.y; o0[3] = v0[2] * t1.y + v0[3] * t1.x;
                        o1[0] = v1[0] * t2.x - v1[1] * t2.y; o1[1] = v1[0] * t2.y + v1[1] * t2.x;
                        o1[2] = v1[2] * t3.x - v1[3] * t3.y; o1[3] = v1[2] * t3.y + v1[3] * t3.x;
                        *(u32x4*)(KR + (size_t)row * 64 + (c0 - 640)) = pack8(o0, o1);
                    } else {
                        const int ch = c0 - 704, g = ch >> 4, h0 = ch & 15, b = row >> 13, t = row & 8191;
                        *(u32x4*)(UX + ((size_t)g * 4096 + b * 512 + (t >> 4)) * 384 + (t & 15) * 16 + h0) = pack8(v0, v1);
                    }
                    asm volatile("" ::: "memory");
                }
        }
    }
};
struct EpiQ {
    static constexpr bool PERM = true, ROWPERM = false, MIDK = false;
    bf16_t* Q; const float* SSQ; const f32x2* CS;
    __device__ __forceinline__ void operator()(const Acc& acc, const Unit& u, int wr, int wc, int fr, int fq) const {
        int rb = u.pm * 256 + wr * 64 + fr;
#pragma unroll
        for (int ai = 0; ai < 2; ++ai)
#pragma unroll
            for (int m = 0; m < 4; ++m) {
                asm volatile("" : "+v"(rb)); const int row = rb + ai * 128 + m * 16;
                const f32x4* sp = (const f32x4*)(SSQ + (size_t)row * 32);
                const float rs = __builtin_amdgcn_rsqf((sum4(sp[0]) + sum4(sp[1]) + sum4(sp[2])) * (1.f / 384.f) + EPS) * QSCALE;
#pragma unroll
                for (int bj = 0; bj < 2; ++bj) {
                    const int gc = u.pn * 256 + bj * 128 + wc * 32, c0 = gc + 8 * fq, w = gc % 192;
                    f32x4 v0 = acc[ai][bj][m][0] * rs, v1 = acc[ai][bj][m][1] * rs;
                    if (w >= 128) {
                        const f32x2* cs = CS + (size_t)row * 32 + ((w - 128 + 8 * fq) >> 1);
                        const f32x2 t0 = cs[0], t1 = cs[1], t2 = cs[2], t3 = cs[3];
                        f32x4 o0, o1;
                        o0[0] = v0[0] * t0.x - v0[1] * t0.y; o0[1] = v0[0] * t0.y + v0[1] * t0.x;
                        o0[2] = v0[2] * t1.x - v0[3] * t1.y; o0[3] = v0[2] * t1.y + v0[3] * t1.x;
                        o1[0] = v1[0] * t2.x - v1[1] * t2.y; o1[1] = v1[0] * t2.y + v1[1] * t2.x;
                        o1[2] = v1[2] * t3.x - v1[3] * t3.y; o1[3] = v1[2] * t3.y + v1[3] * t3.x;
                        v0 = o0; v1 = o1;
                    }
                    *(u32x4*)(Q + (size_t)row * 768 + c0) = pack8(v0, v1);
                }
                asm volatile("" ::: "memory");
            }
    }
};
struct EpiKV {
    static constexpr bool PERM = true, ROWPERM = true, MIDK = false;
    bf16_t* KN; bf16_t* VT; const float* SSQ;
    __device__ __forceinline__ void operator()(const Acc& acc, const Unit& u, int wr, int wc, int fr, int fq) const {
        int tok0 = u.pm * 256 + 8 * (16 * wr + fr); const int h = u.pn;
        float rs[8];
#pragma unroll
        for (int j = 0; j < 8; ++j) { asm volatile("" : "+v"(tok0)); const f32x4* sp = (const f32x4*)(SSQ + (size_t)(tok0 + j) * 32 + 12); rs[j] = __builtin_amdgcn_rsqf((sum4(sp[0]) + sum4(sp[1])) * (1.f / 256.f) + EPS); }
        const int c0 = wc * 32 + 8 * fq;
#pragma unroll
        for (int ai = 0; ai < 2; ++ai)
#pragma unroll
            for (int m = 0; m < 4; ++m) { const int j = 4 * ai + m; asm volatile("" : "+v"(tok0));
                *(u32x4*)(KN + (size_t)(tok0 + j) * 512 + h * 128 + c0) = pack8(acc[ai][0][m][0] * rs[j], acc[ai][0][m][1] * rs[j]); asm volatile("" ::: "memory"); }
        const int b = tok0 >> 13, t0 = tok0 & 8191;
        bf16_t* vb = VT + ((size_t)(b * 4 + h) * 128 + c0) * 8192 + t0;
#pragma unroll
        for (int e = 0; e < 8; ++e) {
            const int n = e >> 2, k = e & 3; u32x4 w;
            w.x = pk2(acc[0][1][0][n][k] * rs[0], acc[0][1][1][n][k] * rs[1]); w.y = pk2(acc[0][1][2][n][k] * rs[2], acc[0][1][3][n][k] * rs[3]);
            w.z = pk2(acc[1][1][0][n][k] * rs[4], acc[1][1][1][n][k] * rs[5]); w.w = pk2(acc[1][1][2][n][k] * rs[6], acc[1][1][3][n][k] * rs[7]);
            *(u32x4*)(vb + (size_t)e * 8192) = w; asm volatile("" ::: "memory");
        }
    }
};
struct EpiS5a {
    static constexpr bool PERM = true, ROWPERM = false, MIDK = false;
    float* SB;
    __device__ __forceinline__ void operator()(const Acc& acc, const Unit& u, int wr, int wc, int fr, int fq) const {
        int rb = u.pm * 256 + wr * 64 + fr;
#pragma unroll
        for (int ai = 0; ai < 2; ++ai)
#pragma unroll
            for (int m = 0; m < 4; ++m) {
                asm volatile("" : "+v"(rb)); const int row = rb + ai * 128 + m * 16;
                float* p = SB + ((size_t)u.g * 4096 + row) * 128 + wc * 32 + 8 * fq;
                *(f32x4*)p = acc[ai][0][m][0]; *(f32x4*)(p + 4) = acc[ai][0][m][1];
            }
    }
};
struct EpiS5c {
    static constexpr bool PERM = true, ROWPERM = false, MIDK = false;
    bf16_t* Y; const bf16_t* UX; const float* Dk;
    __device__ __forceinline__ void operator()(const Acc& acc, const Unit& u, int wr, int wc, int fr, int fq) const {
        int rb = u.pm * 256 + wr * 64 + fr;
#pragma unroll
        for (int bj = 0; bj < 2; ++bj) {
            const int n0 = bj * 128 + wc * 32 + 8 * fq, i = n0 >> 4, h0 = n0 & 15;
#pragma unroll
            for (int ai = 0; ai < 2; ++ai)
#pragma unroll
                for (int m = 0; m < 4; ++m) {
                    asm volatile("" : "+v"(rb)); const int row = rb + ai * 128 + m * 16;
                    const u32x4 uu = *(const u32x4*)(UX + ((size_t)u.g * 4096 + row) * 384 + n0);
                    const f32x4 d0 = *(const f32x4*)(Dk + u.g * 16 + h0), d1 = *(const f32x4*)(Dk + u.g * 16 + h0 + 4);
                    f32x4 y0 = acc[ai][bj][m][0], y1 = acc[ai][bj][m][1];
                    y0[0] += d0[0] * bflo(uu.x); y0[1] += d0[1] * bfhi(uu.x); y0[2] += d0[2] * bflo(uu.y); y0[3] += d0[3] * bfhi(uu.y);
                    y1[0] += d1[0] * bflo(uu.z); y1[1] += d1[1] * bfhi(uu.z); y1[2] += d1[2] * bflo(uu.w); y1[3] += d1[3] * bfhi(uu.w);
#pragma unroll
                    for (int k = 0; k < 4; ++k) { y0[k] = gelu_t(y0[k]); y1[k] = gelu_t(y1[k]); }
                    const size_t tok = (size_t)(row >> 9) * 8192 + (size_t)(row & 511) * 16 + i;
                    *(u32x4*)(Y + tok * 512 + u.g * 16 + h0) = pack8(y0, y1); asm volatile("" ::: "memory");
                }
        }
    }
};
struct EpiGLU {
    static constexpr bool PERM = true, ROWPERM = false, MIDK = false;
    bf16_t* AS; float* SSQ; const float* bias;
    __device__ __forceinline__ void operator()(const Acc& acc, const Unit& u, int wr, int wc, int fr, int fq) const {
        int rb = u.pm * 256 + wr * 64 + fr;
        const int sc = u.pn * 128 + wc * 32 + 8 * fq;
        const f32x4 bv0 = *(const f32x4*)(bias + sc), bv1 = *(const f32x4*)(bias + sc + 4), bg0 = *(const f32x4*)(bias + 512 + sc), bg1 = *(const f32x4*)(bias + 512 + sc + 4);
#pragma unroll
        for (int ai = 0; ai < 2; ++ai)
#pragma unroll
            for (int m = 0; m < 4; ++m) {
                asm volatile("" : "+v"(rb)); const int row = rb + ai * 128 + m * 16;
                f32x4 o0, o1;
#pragma unroll
                for (int k = 0; k < 4; ++k) { o0[k] = (acc[ai][0][m][0][k] + bv0[k]) * sigmoid_f(acc[ai][1][m][0][k] + bg0[k]); o1[k] = (acc[ai][0][m][1][k] + bv1[k]) * sigmoid_f(acc[ai][1][m][1][k] + bg1[k]); }
                *(u32x4*)(AS + (size_t)row * 1024 + 512 + sc) = pack8(o0, o1);
                const float ss = red_fq(dot4(o0) + dot4(o1));
                if (fq == 0) SSQ[(size_t)row * 16 + u.pn * 4 + wc] = ss; asm volatile("" ::: "memory");
            }
    }
};
struct EpiRes {
    static constexpr bool PERM = true, ROWPERM = false, MIDK = false;
    const float* base; float* out; const float* gate; float* SSQ;
    __device__ __forceinline__ void operator()(const Acc& acc, const Unit& u, int wr, int wc, int fr, int fq) const {
        int rb = u.pm * 256 + wr * 64 + fr;
        const int b = u.pm >> 5;
#pragma unroll
        for (int bj = 0; bj < 2; ++bj) {
            const int c0 = u.pn * 256 + bj * 128 + wc * 32 + 8 * fq;
            const f32x4 g0 = *(const f32x4*)(gate + b * 6144 + c0), g1 = *(const f32x4*)(gate + b * 6144 + c0 + 4);
#pragma unroll
            for (int ai = 0; ai < 2; ++ai)
#pragma unroll
                for (int m = 0; m < 4; ++m) {
                    asm volatile("" : "+v"(rb)); const int row = rb + ai * 128 + m * 16;
                    const size_t off = (size_t)row * 1024 + c0;
                    const f32x4 x0 = *(const f32x4*)(base + off), x1 = *(const f32x4*)(base + off + 4);
                    const f32x4 o0 = x0 + g0 * acc[ai][bj][m][0], o1 = x1 + g1 * acc[ai][bj][m][1];
                    *(f32x4*)(out + off) = o0; *(f32x4*)(out + off + 4) = o1;
                    const float ss = red_fq(dot4(o0) + dot4(o1));
                    if (fq == 0) SSQ[(size_t)row * 32 + u.pn * 8 + bj * 4 + wc] = ss; asm volatile("" ::: "memory");
                }
        }
    }
};
struct EpiOut {
    static constexpr bool PERM = true, ROWPERM = false, MIDK = true;
    const float* base; float* out; const float* gate; float* SSQ; const float* RST;
    __device__ __forceinline__ void mid(Acc& acc, const Unit& u, int wr, int wc, int fr, int fq) const {
        int rb = u.pm * 256 + wr * 64 + fr;
#pragma unroll
        for (int ai = 0; ai < 2; ++ai)
#pragma unroll
            for (int m = 0; m < 4; ++m) {
                asm volatile("" : "+v"(rb)); const float r = RST[(size_t)(rb + ai * 128 + m * 16) * 4];
                acc[ai][0][m][0] *= r; acc[ai][0][m][1] *= r; acc[ai][1][m][0] *= r; acc[ai][1][m][1] *= r;
            }
    }
    __device__ __forceinline__ void operator()(const Acc& acc, const Unit& u, int wr, int wc, int fr, int fq) const {
        int rb = u.pm * 256 + wr * 64 + fr;
        const int b = u.pm >> 5;
#pragma unroll
        for (int bj = 0; bj < 2; ++bj) {
            const int c0 = u.pn * 256 + bj * 128 + wc * 32 + 8 * fq;
            const f32x4 g0 = *(const f32x4*)(gate + b * 6144 + c0), g1 = *(const f32x4*)(gate + b * 6144 + c0 + 4);
#pragma unroll
            for (int ai = 0; ai < 2; ++ai)
#pragma unroll
                for (int m = 0; m < 4; ++m) {
                    asm volatile("" : "+v"(rb)); const int row = rb + ai * 128 + m * 16;
                    const size_t off = (size_t)row * 1024 + c0;
                    const float rss = RST[(size_t)row * 4 + 1];
                    const f32x4 x0 = *(const f32x4*)(base + off), x1 = *(const f32x4*)(base + off + 4);
                    const f32x4 o0 = x0 + g0 * (acc[ai][bj][m][0] * rss), o1 = x1 + g1 * (acc[ai][bj][m][1] * rss);
                    *(f32x4*)(out + off) = o0; *(f32x4*)(out + off + 4) = o1;
                    const float ss = red_fq(dot4(o0) + dot4(o1));
                    if (fq == 0) SSQ[(size_t)row * 32 + u.pn * 8 + bj * 4 + wc] = ss; asm volatile("" ::: "memory");
                }
        }
    }
};
struct EpiUp {
    static constexpr bool PERM = true, ROWPERM = true, MIDK = false;
    bf16_t* ACT; float* HALO; float* FIX; const float* cw; const float* cb;
    __device__ __forceinline__ void operator()(const Acc& acc, const Unit& u, int wr, int wc, int fr, int fq) const {
        const int tok0 = u.pm * 256 + 8 * (16 * wr + fr), cg0 = u.pn * 128 + wc * 32 + 8 * fq;
        unsigned pk[8][4];
#pragma unroll
        for (int pp = 0; pp < 4; ++pp) {
            float a2[2][8];
#pragma unroll
            for (int q = 0; q < 2; ++q) {
                const int e = 2 * pp + q, n = e >> 2, k = e & 3, col = cg0 + e;
                const float w0 = cw[col], w1 = cw[DFF + col], w2 = cw[2 * DFF + col], bb = cb[col];
                float g[8], v[8];
#pragma unroll
                for (int j = 0; j < 8; ++j) { g[j] = acc[j >> 2][0][j & 3][n][k]; v[j] = acc[j >> 2][1][j & 3][n][k]; }
                const float p7 = __int_as_float(__builtin_amdgcn_update_dpp(__float_as_int(g[7]), __float_as_int(g[7]), 0x111, 0xf, 0xf, false)),
                            p6 = __int_as_float(__builtin_amdgcn_update_dpp(__float_as_int(g[6]), __float_as_int(g[6]), 0x111, 0xf, 0xf, false));
                a2[q][0] = gelu_t(bb + w0 * p6 + w1 * p7 + w2 * g[0]) * v[0];
                a2[q][1] = gelu_t(bb + w0 * p7 + w1 * g[0] + w2 * g[1]) * v[1];
#pragma unroll
                for (int j = 2; j < 8; ++j) a2[q][j] = gelu_t(bb + w0 * g[j - 2] + w1 * g[j - 1] + w2 * g[j]) * v[j];
                if (fr == 0) { float* f = FIX + ((size_t)(u.pm * 2 + wr) * 4) * DFF + col; f[0] = g[0]; f[DFF] = v[0]; f[2 * DFF] = g[1]; f[3 * DFF] = v[1]; }
                if (fr == 15) { float* hp = HALO + ((size_t)(u.pm * 2 + wr) * 2) * DFF + col; hp[0] = g[6]; hp[DFF] = g[7]; }
            }
#pragma unroll
            for (int j = 0; j < 8; ++j) pk[j][pp] = pk2(a2[0][j], a2[1][j]);
        }
#pragma unroll
        for (int j = 0; j < 8; ++j) {
            if (j < 2 && fr == 0) continue;
            u32x4 w; w.x = pk[j][0]; w.y = pk[j][1]; w.z = pk[j][2]; w.w = pk[j][3];
            *(u32x4*)(ACT + (size_t)(tok0 + j) * DFF + cg0) = w;
        }
    }
};

namespace att {
constexpr int KROW = 400, VROW = 144, KBUF = 64 * KROW, VBUF = 128 * VROW, OFF_V = 2 * KBUF, LDS_BYTES = OFF_V + 2 * VBUF;
__device__ __forceinline__ void attn_unit(int b, int h, int qb, const bf16_t* __restrict__ Q, const bf16_t* __restrict__ KN, const bf16_t* __restrict__ KR, const bf16_t* __restrict__ VT,
                                          bf16_t* AS, float* ASSQ, LAS unsigned char* lds) {
    int tid_ = threadIdx.x; asm volatile("" : "+v"(tid_));
    const int tid = tid_, lane = tid & 63, wid = __builtin_amdgcn_readfirstlane(tid >> 6), q = lane & 31, hi = lane >> 5;
    const size_t tokb = (size_t)b * 8192;
    const int qrel = wid * 32 + q, qrow = qb * 256 + qrel;
    bf16x8 qf[12];
    { const bf16_t* qp = Q + (tokb + qrow) * 768 + h * 192 + hi * 8;
#pragma unroll
      for (int s = 0; s < 12; ++s) qf[s] = *(const bf16x8*)(qp + s * 16); }
    const bf16_t* ksrc[3]; int kstr[3]; unsigned kdst[3];
#pragma unroll
    for (int i = 0; i < 3; ++i) { const int p = tid + 512 * i, key = p / 24, pc = p % 24;
        if (pc < 16) { ksrc[i] = KN + (tokb + key) * 512 + h * 128 + pc * 8; kstr[i] = 64 * 512; } else { ksrc[i] = KR + (tokb + key) * 64 + (pc - 16) * 8; kstr[i] = 64 * 64; }
        kdst[i] = (unsigned)(key * KROW + pc * 16); }
    const bf16_t* vsrc[2]; unsigned vdst[2];
#pragma unroll
    for (int i = 0; i < 2; ++i) { const int p = tid + 512 * i, dv = p >> 3, pc = p & 7; vsrc[i] = VT + ((size_t)(b * 4 + h) * 128 + dv) * 8192 + pc * 8; vdst[i] = (unsigned)(OFF_V + dv * VROW + pc * 16); }
    const int ntile = 4 * (qb + 1);
    u32x4 st[5];
#define ATT_LOAD(t) do { _Pragma("unroll") for (int i = 0; i < 3; ++i) st[i] = *(const u32x4*)(ksrc[i] + (size_t)(t) * kstr[i]); \
                         _Pragma("unroll") for (int i = 0; i < 2; ++i) st[3 + i] = *(const u32x4*)(vsrc[i] + (size_t)(t) * 64); } while (0)
#define ATT_WRITE(buf) do { _Pragma("unroll") for (int i = 0; i < 3; ++i) *(LAS u32x4*)(lds + (buf) * KBUF + kdst[i]) = st[i]; \
                            _Pragma("unroll") for (int i = 0; i < 2; ++i) *(LAS u32x4*)(lds + (buf) * VBUF + vdst[i]) = st[3 + i]; } while (0)
    ATT_LOAD(0); ATT_WRITE(0);
    const int i16 = q & 15;
    const int krow = 16 * (q >> 4) + 8 * ((i16 >> 2) & 1) + (i16 & 3) + 4 * (i16 >> 3);
    const unsigned kaddr = (unsigned)(krow * KROW + hi * 16), vaddr = (unsigned)(OFF_V + q * VROW + hi * 16);
    float mrun = 0.f, lrun = 0.f;
    f32x16 o[4], negm;
#pragma unroll
    for (int r = 0; r < 16; ++r) negm[r] = 0.f;
#pragma unroll
    for (int k = 0; k < 4; ++k)
#pragma unroll
        for (int r = 0; r < 16; ++r) o[k][r] = 0.f;
    for (int t = 0; t < ntile; ++t) {
        if (t + 1 < ntile) ATT_LOAD(t + 1);
        __syncthreads();
        const int jb = t - (ntile - 4);
        if (!(jb >= 0 && 64 * jb > 32 * wid + 31)) {
            const unsigned kb = (unsigned)((t & 1) * KBUF) + kaddr, vb = (unsigned)((t & 1) * VBUF) + vaddr;
            f32x16 p0, p1;
            __builtin_amdgcn_s_setprio(1);
            { const bf16x8 a0 = *(const LAS bf16x8*)(lds + kb), a1 = *(const LAS bf16x8*)(lds + kb + 32 * KROW);
              p0 = __builtin_amdgcn_mfma_f32_32x32x16_bf16(a0, qf[0], negm, 0, 0, 0);
              p1 = __builtin_amdgcn_mfma_f32_32x32x16_bf16(a1, qf[0], negm, 0, 0, 0); }
#pragma unroll
            for (int s = 1; s < 12; ++s) {
                const bf16x8 a0 = *(const LAS bf16x8*)(lds + kb + s * 32), a1 = *(const LAS bf16x8*)(lds + kb + 32 * KROW + s * 32);
                p0 = __builtin_amdgcn_mfma_f32_32x32x16_bf16(a0, qf[s], p0, 0, 0, 0);
                p1 = __builtin_amdgcn_mfma_f32_32x32x16_bf16(a1, qf[s], p1, 0, 0, 0);
            }
            __builtin_amdgcn_s_setprio(0);
            if (jb >= 0) {
#pragma unroll
                for (int r = 0; r < 16; ++r) { const int kp = 64 * jb + 16 * (r >> 3) + 8 * hi + (r & 7);
                    if (kp > qrel) p0[r] = -INFINITY; if (kp + 32 > qrel) p1[r] = -INFINITY; }
            }
            float mx, mx2;
            asm("v_max3_f32 %0, %1, %2, %3" : "=v"(mx) : "v"(p0[0]), "v"(p1[0]), "v"(p0[1]));
            asm("v_max3_f32 %0, %1, %2, %3" : "=v"(mx2) : "v"(p1[1]), "v"(p0[2]), "v"(p1[2]));
#pragma unroll
            for (int r = 3; r < 15; r += 2) { asm("v_max3_f32 %0, %1, %2, %3" : "=v"(mx) : "v"(mx), "v"(p0[r]), "v"(p1[r])); asm("v_max3_f32 %0, %1, %2, %3" : "=v"(mx2) : "v"(mx2), "v"(p0[r + 1]), "v"(p1[r + 1])); }
            asm("v_max3_f32 %0, %1, %2, %3" : "=v"(mx) : "v"(mx), "v"(p0[15]), "v"(p1[15]));
            mx = fmaxf(mx, mx2);
            mx = fmaxf(mx, __shfl_xor(mx, 32));
            if (t == 0) {
                mrun = mx;
#pragma unroll
                for (int r = 0; r < 16; ++r) { p0[r] -= mx; p1[r] -= mx; negm[r] = -mx; }
            } else if (__any(mx > 8.f)) {
                const float d = fmaxf(mx, 0.f), f = __builtin_amdgcn_exp2f(-d);
                mrun += d; lrun *= f;
#pragma unroll
                for (int r = 0; r < 16; ++r) { p0[r] -= d; p1[r] -= d; negm[r] = -mrun; }
#pragma unroll
                for (int k = 0; k < 4; ++k)
#pragma unroll
                    for (int r = 0; r < 16; ++r) o[k][r] *= f;
            }
            float rs = 0.f, rs2 = 0.f, one = 1.f;
            asm volatile("" : "+v"(one));
#pragma unroll
            for (int r = 0; r < 16; ++r) { p0[r] = __builtin_amdgcn_exp2f(p0[r]); p1[r] = __builtin_amdgcn_exp2f(p1[r]); rs = __builtin_fmaf(p0[r], one, rs); rs2 = __builtin_fmaf(p1[r], one, rs2); }
            lrun += rs + rs2;
            bf16x8 pb[4];
            { u32x4 w;
              w.x = pk2(p0[0], p0[1]); w.y = pk2(p0[2], p0[3]); w.z = pk2(p0[4], p0[5]); w.w = pk2(p0[6], p0[7]); pb[0] = __builtin_bit_cast(bf16x8, w);
              w.x = pk2(p0[8], p0[9]); w.y = pk2(p0[10], p0[11]); w.z = pk2(p0[12], p0[13]); w.w = pk2(p0[14], p0[15]); pb[1] = __builtin_bit_cast(bf16x8, w);
              w.x = pk2(p1[0], p1[1]); w.y = pk2(p1[2], p1[3]); w.z = pk2(p1[4], p1[5]); w.w = pk2(p1[6], p1[7]); pb[2] = __builtin_bit_cast(bf16x8, w);
              w.x = pk2(p1[8], p1[9]); w.y = pk2(p1[10], p1[11]); w.z = pk2(p1[12], p1[13]); w.w = pk2(p1[14], p1[15]); pb[3] = __builtin_bit_cast(bf16x8, w); }
            __builtin_amdgcn_s_setprio(1);
#pragma unroll
            for (int k = 0; k < 4; ++k)
#pragma unroll
                for (int ks = 0; ks < 4; ++ks) {
                    const bf16x8 va = *(const LAS bf16x8*)(lds + vb + k * 32 * VROW + ks * 32);
                    o[k] = __builtin_amdgcn_mfma_f32_32x32x16_bf16(va, pb[ks], o[k], 0, 0, 0);
                }
            __builtin_amdgcn_s_setprio(0);
        }
        if (t + 1 < ntile) ATT_WRITE((t + 1) & 1);
    }
#undef ATT_LOAD
#undef ATT_WRITE
    const float ltot = lrun + __shfl_xor(lrun, 32), inv = 1.f / ltot;
    float ss = 0.f;
    bf16_t* op = AS + (tokb + qrow) * 1024 + h * 128 + 4 * hi;
#pragma unroll
    for (int k = 0; k < 4; ++k)
#pragma unroll
        for (int rg = 0; rg < 4; ++rg) {
            const float v0 = o[k][4 * rg] * inv, v1 = o[k][4 * rg + 1] * inv, v2 = o[k][4 * rg + 2] * inv, v3 = o[k][4 * rg + 3] * inv;
            ss += (v0 * v0 + v1 * v1) + (v2 * v2 + v3 * v3);
            u32x2 w; w.x = pk2(v0, v1); w.y = pk2(v2, v3);
            *(u32x2*)(op + 32 * k + 8 * rg) = w;
        }
    ss += __shfl_xor(ss, 32);
    if (hi == 0) ASSQ[(tokb + qrow) * 4 + h] = ss;
    __syncthreads();
}
}


#define XB_TMO      128
#define XB_XCNT(j)  (256  + 64 * (j))
#define XB_XSUB(j)  (1280 + 64 * (j))
#define XB_XGEN(j)  (2304 + 64 * (j))
#define XB_TOP      3328
#define XB_TOPGEN   3392
#define XCD_BAR_WORDS 3456
#define XB_SPIN_CAP (1u << 18)
__device__ __forceinline__ unsigned xb_ld(unsigned* p)              { return __hip_atomic_load(p, __ATOMIC_RELAXED, __HIP_MEMORY_SCOPE_AGENT); }
__device__ __forceinline__ unsigned xb_add(unsigned* p, unsigned v) { return __hip_atomic_fetch_add(p, v, __ATOMIC_RELAXED, __HIP_MEMORY_SCOPE_AGENT); }
__device__ __forceinline__ unsigned xb_xcc_id() { return (unsigned)__builtin_amdgcn_s_getreg((3 << 11) | 20) & 0xFu; }
#define XB_SPIN(cond, bar) do { unsigned _sp = 0; while (cond) { __builtin_amdgcn_s_sleep(1); \
    if ((++_sp & 255u) == 0u) { if (xb_ld(&(bar)[XB_TMO])) break; if (_sp > XB_SPIN_CAP) { atomicAdd(&(bar)[XB_TMO], 1u); break; } } } } while (0)
struct XcdBarrier { unsigned* bar; unsigned x; volatile LAS unsigned* st; };
__device__ __forceinline__ XcdBarrier xcd_barrier_post(unsigned* bar, volatile LAS unsigned* st) {
    XcdBarrier b; b.bar = bar; b.x = xb_xcc_id(); b.st = st;
    if (threadIdx.x == 0) (void)xb_add(&bar[XB_XCNT(b.x)], 1u);
    return b;
}
__device__ __forceinline__ void xcd_barrier_complete(unsigned* bar, unsigned x, unsigned& nloc, unsigned& nx) {
    const unsigned G = gridDim.x * gridDim.y * gridDim.z;
    unsigned sum, cnt, mine, sp = 0u;
    for (;;) {
        sum = 0u; cnt = 0u; mine = 0u;
#pragma unroll
        for (unsigned j = 0; j < 16; ++j) { const unsigned c = xb_ld(&bar[XB_XCNT(j)]); sum += c; cnt += (c > 0u) ? 1u : 0u; mine = (j == x) ? c : mine; }
        if (sum == G) break;
        __builtin_amdgcn_s_sleep(1);
        if ((++sp & 255u) == 0u) { if (xb_ld(&bar[XB_TMO])) break; if (sp > XB_SPIN_CAP) { atomicAdd(&bar[XB_TMO], 1u); break; } }
    }
    nloc = mine > 0u ? mine : 1u; nx = cnt > 0u ? cnt : 1u;
}
__device__ __forceinline__ void xcd_barrier(const XcdBarrier& b) {
    asm volatile("s_waitcnt vmcnt(0)" ::: "memory");
    __syncthreads();
    if (threadIdx.x == 0) {
        unsigned* bar = b.bar;
        __builtin_amdgcn_s_waitcnt(0);
        unsigned nloc = b.st[0], nx = b.st[1];
        if (nloc == 0u) { xcd_barrier_complete(bar, b.x, nloc, nx); b.st[0] = nloc; b.st[1] = nx; }
        const unsigned old = xb_add(&bar[XB_XSUB(b.x)], 1u);
        const unsigned gen = old / nloc;
        if (old + 1u == (gen + 1u) * nloc) {
            __builtin_amdgcn_fence(__ATOMIC_RELEASE, "agent");
            asm volatile("s_waitcnt vmcnt(0)" ::: "memory");
            const unsigned og = xb_add(&bar[XB_TOP], 1u);
            const unsigned tg = og / nx;
            if (og + 1u == (tg + 1u) * nx) xb_add(&bar[XB_TOPGEN], 1u);
            else XB_SPIN(xb_ld(&bar[XB_TOPGEN]) == tg, bar);
            __builtin_amdgcn_fence(__ATOMIC_ACQUIRE, "agent");
            xb_add(&bar[XB_XGEN(b.x)], 1u);
            asm volatile("s_waitcnt vmcnt(0)" ::: "memory");
        } else {
            XB_SPIN(xb_ld(&bar[XB_XGEN(b.x)]) == gen, bar);
            __builtin_amdgcn_fence(__ATOMIC_ACQUIRE, "agent");
            asm volatile("s_waitcnt vmcnt(0)" ::: "memory");
        }
    }
    __syncthreads();
}
struct Args { const void* in[30]; float* out; unsigned char* ws; };

__device__ __forceinline__ void blk_sync_mem() { __threadfence_block(); __syncthreads(); }

template <class SrcCol, class KScale>
__device__ __forceinline__ void transpose_item(const float* __restrict__ W, int K, int N, bf16_t* WT, int nout, LAS float* scr, int item, int lane, SrcCol sc, KScale ks) {
    const int nblk = nout / 32, kb = item / nblk, nb = item % nblk, k0 = 64 * kb, n0 = 32 * nb;
    const int src = sc(n0 + (lane & 31));
#pragma unroll 8
    for (int i = 0; i < 32; ++i) { const int kk = 2 * i + (lane >> 5); scr[kk * 33 + (lane & 31)] = src >= 0 ? W[(size_t)(k0 + kk) * N + src] * ks(k0 + kk) : 0.f; }
    asm volatile("s_waitcnt lgkmcnt(0)" ::: "memory");
    const int c = lane & 7;
#pragma unroll
    for (int j = 0; j < 4; ++j) { const int n = (lane >> 3) + 8 * j; const LAS float* s = scr + (8 * c) * 33 + n;
        u32x4 o; o.x = pk2(s[0 * 33], s[1 * 33]); o.y = pk2(s[2 * 33], s[3 * 33]); o.z = pk2(s[4 * 33], s[5 * 33]); o.w = pk2(s[6 * 33], s[7 * 33]);
        *(u32x4*)(WT + (size_t)(n0 + n) * K + k0 + 8 * c) = o; }
    asm volatile("s_waitcnt lgkmcnt(0)" ::: "memory");
}
__device__ __forceinline__ void cpowd(double lrdt, double lidt, int e, double& re, double& im) { const double mag = exp(lrdt * e), a = lidt * e; re = mag * cos(a); im = mag * sin(a); }

__device__ __forceinline__ const float* ldarg(int i) {
    const __attribute__((address_space(4))) char* kp = (const __attribute__((address_space(4))) char*)__builtin_amdgcn_kernarg_segment_ptr();
    int off = i * 8; asm volatile("" : "+s"(off));
    return *(const float* const __attribute__((address_space(4)))*)(kp + off);
}
#define WT_in ((bf16_t*)(ws + WS_WIN))
#define WT_uq ((bf16_t*)(ws + WS_WUQ))
#define WT_ukv ((bf16_t*)(ws + WS_WUKV))
#define WT_glu ((bf16_t*)(ws + WS_WGLU))
#define WT_out ((bf16_t*)(ws + WS_WOUT))
#define WT_up ((bf16_t*)(ws + WS_WUP))
#define WT_down ((bf16_t*)(ws + WS_WDOWN))
#define WS5S ((bf16_t*)(ws + WS_WS5S))
#define WS5T ((bf16_t*)(ws + WS_WS5T))
#define MOD ((float*)(ws + WS_MOD))
#define A16 ((f32x2*)(ws + WS_MOD + 512 * 1024))
#define CS ((f32x2*)(ws + WS_CS))
#define SSQ1 ((float*)(ws + WS_SSQ1))
#define ASSQ ((float*)(ws + WS_ASSQ))
#define SSQ2 ((float*)(ws + WS_SSQ2))
#define SSQ3 ((float*)(ws + WS_SSQ3))
#define SSQ4 ((float*)(ws + WS_SSQ4))
#define HALO ((float*)(ws + WS_HALO))
#define FIX ((float*)(ws + WS_FIX))
#define YSSM ((bf16_t*)(ws + WS_YSSM))
#define AS ((bf16_t*)(ws + WS_AS))
#define H1 ((bf16_t*)(ws + WS_H1))
#define Z ((bf16_t*)(ws + WS_Z))
#define UX ((bf16_t*)(ws + WS_UX))
#define SB ((float*)(ws + WS_SB))
#define Qb ((bf16_t*)(ws + WS_Q))
#define KN ((bf16_t*)(ws + WS_KN))
#define VT ((bf16_t*)(ws + WS_VT))
#define KR ((bf16_t*)(ws + WS_KR))
#define H2 ((bf16_t*)(ws + WS_H2))
#define RST ((float*)(ws + WS_RST))
#define ACT ((bf16_t*)(ws + WS_ACT))
#define PHASE_IDS int tid_l = threadIdx.x; asm volatile("" : "+v"(tid_l)); const int tid = tid_l, lane = tid & 63, wid = __builtin_amdgcn_readfirstlane(tid >> 6), gw = bx * 8 + wid; (void)gw; (void)lane; (void)tid;
__global__ void __launch_bounds__(512, 2) fwd_kernel(Args a) {
    extern __shared__ __attribute__((aligned(16))) unsigned char lds_raw[];
    LAS unsigned char* lds = (LAS unsigned char*)lds_raw;
    cg::grid_group grid = cg::this_grid();
    const int tid = threadIdx.x, lane = tid & 63, wid = __builtin_amdgcn_readfirstlane(tid >> 6);
    const int G = gridDim.x, bx = blockIdx.x, gw = bx * 8 + wid, NGW = G * 8;
    volatile LAS unsigned* bst = (volatile LAS unsigned*)(lds + 139264);
    if (tid < 4) bst[tid] = 0u;
    __syncthreads();
    const XcdBarrier xbar = xcd_barrier_post((unsigned*)(a.ws + WS_BAR), bst);
    float* const out = a.out; unsigned char* const ws = a.ws;
#if PHM & 1
    { PHASE_IDS
    REP(1) {
        LAS float* cond = (LAS float*)lds;
        LAS float* red = (LAS float*)(lds + 32768);
        const float* cvec = ldarg(1); const float* w_mod = ldarg(3); const float* b_mod = ldarg(4);
        for (int cb = bx; cb < 96; cb += G) {
            for (int i = tid; i < 8192; i += 512) { const float v = cvec[i]; cond[i] = v * sigmoid_f(v); }
            __syncthreads();
            float accb[8];
#pragma unroll
            for (int b = 0; b < 8; ++b) accb[b] = 0.f;
            const int col = cb * 64 + lane;
#pragma unroll 8
            for (int k = wid * 128; k < wid * 128 + 128; ++k) { const float wv = w_mod[(size_t)k * 6144 + col];
#pragma unroll
                for (int b = 0; b < 8; ++b) accb[b] += cond[b * 1024 + k] * wv; }
#pragma unroll
            for (int b = 0; b < 8; ++b) red[(wid * 8 + b) * 64 + lane] = accb[b];
            __syncthreads();
            { float s = b_mod[col];
#pragma unroll
              for (int w = 0; w < 8; ++w) s += red[(w * 8 + wid) * 64 + lane];
              MOD[wid * 6144 + col] = s; }
            __syncthreads();
        }
        __syncthreads();
        LAS float* scr = (LAS float*)(lds + wid * 16384);
        constexpr int I_IN = 16 * 40, I_UQ = 6 * 24, I_UKV = 4 * 32, I_GLU = 8 * 32, I_OUT = 16 * 32, I_UP = 16 * 176, I_DOWN = 44 * 32, I_S5 = 512;
        constexpr int NITEMS = I_IN + I_UQ + I_UKV + I_GLU + I_OUT + I_UP + I_DOWN + I_S5;
        for (int it = gw; it < NITEMS; it += NGW) {
            int r = it;
            if (r < I_S5) {
                const int g = r >> 4, d = r & 15, p = lane;
                const float* lam_re = ldarg(11); const float* lam_im = ldarg(12); const float* log_dt = ldarg(13); const float* b_re = ldarg(14); const float* b_im = ldarg(15); const float* c_re = ldarg(16); const float* c_im = ldarg(17);
                const double lr = (double)fminf(lam_re[g * 64 + p], -1e-4f), li = (double)lam_im[g * 64 + p], dt = exp((double)log_dt[g]);
                const double lrdt = lr * dt, lidt = li * dt;
                double are, aim; cpowd(lrdt, lidt, 1, are, aim);
                const double nr = are - 1.0, ni = aim, den = lr * lr + li * li;
                const double zre = (nr * lr + ni * li) / den, zim = (ni * lr - nr * li) / den;
                double e_re, e_im;
                cpowd(lrdt, lidt, d, e_re, e_im);
                scr[p] = (float)(e_re * zre - e_im * zim); scr[64 + p] = (float)(e_re * zim + e_im * zre);
                asm volatile("s_waitcnt lgkmcnt(0)" ::: "memory");
                bf16_t* Tg = WS5T + (size_t)g * 256 * 384; bf16_t* Sg = WS5S + (size_t)g * 256 * 256;
#pragma unroll 1
                for (int k4 = 0; k4 < 4; ++k4) {
                    const int idx = lane + 64 * k4, h = idx >> 4, hp = idx & 15;
                    float s = 0.f;
                    for (int pp = 0; pp < 64; ++pp) {
                        const float Cr = c_re[(g * 16 + h) * 64 + pp], Ci = c_im[(g * 16 + h) * 64 + pp], Br = b_re[(g * 64 + pp) * 16 + hp], Bi = b_im[(g * 64 + pp) * 16 + hp];
                        const float Wr = scr[pp], Wi = scr[64 + pp];
                        s += (Cr * Wr - Ci * Wi) * Br - (Cr * Wi + Ci * Wr) * Bi;
                    }
                    const bf16_t kv = (bf16_t)(pk2(s, 0.f) & 0xffffu);
                    for (int i = d; i < 16; ++i) Tg[(size_t)(i * 16 + h) * 384 + (i - d) * 16 + hp] = kv;
                    if (d >= 1) for (int i = 0; i + d < 16; ++i) Tg[(size_t)(i * 16 + h) * 384 + (i + d) * 16 + hp] = 0;
                }
                cpowd(lrdt, lidt, d + 1, e_re, e_im);
                for (int h = 0; h < 16; ++h) { const double Cr = c_re[(g * 16 + h) * 64 + p], Ci = c_im[(g * 16 + h) * 64 + p];
                    Tg[(size_t)(d * 16 + h) * 384 + 256 + p] = (bf16_t)(pk2((float)(Cr * e_re - Ci * e_im), 0.f) & 0xffffu);
                    Tg[(size_t)(d * 16 + h) * 384 + 320 + p] = (bf16_t)(pk2((float)(-(Cr * e_im + Ci * e_re)), 0.f) & 0xffffu); }
                cpowd(lrdt, lidt, 15 - d, e_re, e_im);
                { const double fr_ = e_re * zre - e_im * zim, fi_ = e_re * zim + e_im * zre;
                  for (int hp = 0; hp < 16; ++hp) { const double Br = b_re[(g * 64 + p) * 16 + hp], Bi = b_im[(g * 64 + p) * 16 + hp];
                      Sg[(size_t)p * 256 + d * 16 + hp] = (bf16_t)(pk2((float)(fr_ * Br - fi_ * Bi), 0.f) & 0xffffu);
                      Sg[(size_t)(64 + p) * 256 + d * 16 + hp] = (bf16_t)(pk2((float)(fr_ * Bi + fi_ * Br), 0.f) & 0xffffu);
                      Sg[(size_t)(128 + p) * 256 + d * 16 + hp] = 0; Sg[(size_t)(192 + p) * 256 + d * 16 + hp] = 0; } }
                if (d == 0) { cpowd(lrdt, lidt, 16, e_re, e_im); A16[g * 64 + p] = (f32x2){(float)e_re, (float)e_im}; }
                asm volatile("s_waitcnt lgkmcnt(0)" ::: "memory");
                continue;
            }
            r -= I_S5;
            auto one = [](int) { return 1.f; };
            if (r < I_IN) { transpose_item(ldarg(6), 1024, NIN, WT_in, NINP, scr, r, lane,
                [](int n) { return n >= NIN ? -1 : (n >= 640 && n < 704) ? 640 + ((n - 640) >> 1) + 32 * ((n - 640) & 1) : n; }, one); continue; } r -= I_IN;
            if (r < I_UQ) { const float* q_norm_g = ldarg(7); transpose_item(ldarg(8), 384, 768, WT_uq, 768, scr, r, lane,
                [](int n) { const int hh = n / 192, w = n % 192; return w < 128 ? n : hh * 192 + 128 + ((w - 128) >> 1) + 32 * ((w - 128) & 1); }, [=](int k) { return q_norm_g[k]; }); continue; } r -= I_UQ;
            if (r < I_UKV) { const float* kv_norm_g = ldarg(9); transpose_item(ldarg(10), 256, 1024, WT_ukv, 1024, scr, r, lane, [](int n) { return n; }, [=](int k) { return kv_norm_g[k]; }); continue; } r -= I_UKV;
            if (r < I_GLU) { transpose_item(ldarg(19), 512, 1024, WT_glu, 1024, scr, r, lane, [](int n) { return 512 * ((n >> 7) & 1) + 128 * (n >> 8) + (n & 127); }, one); continue; } r -= I_GLU;
            if (r < I_OUT) { const float* attn_out_g = ldarg(21); const float* ssm_out_g = ldarg(22); transpose_item(ldarg(23), 1024, 1024, WT_out, 1024, scr, r, lane, [](int n) { return n; }, [=](int k) { return k < 512 ? attn_out_g[k] : ssm_out_g[k - 512]; }); continue; } r -= I_OUT;
            if (r < I_UP) { transpose_item(ldarg(25), 1024, 2 * DFF, WT_up, 2 * DFF, scr, r, lane, [](int n) { return DFF * ((n >> 7) & 1) + 128 * (n >> 8) + (n & 127); }, one); continue; } r -= I_UP;
            transpose_item(ldarg(28), DFF, 1024, WT_down, 1024, scr, r, lane, [](int n) { return n; }, one);
        }
        {
            LAS double* invf = (LAS double*)lds;
            __syncthreads();
            if (tid < 32) invf[tid] = exp2(-(double)tid * (13.287712379549449 / 32.0)) * 0.15915494309189535;
            __syncthreads();
            const int* pos = (const int*)ldarg(2);
            for (size_t i = (size_t)bx * 512 + tid; i < (size_t)NT * 32; i += (size_t)G * 512) {
                const int t = (int)(i >> 5), f = (int)(i & 31);
                double rv = (double)pos[t] * invf[f]; rv -= rint(rv);
                const float fr = (float)rv;
                CS[i] = (f32x2){__builtin_amdgcn_cosf(fr), __builtin_amdgcn_sinf(fr)};
            }
        }
        __syncthreads();
    }
    grid.sync();

    }
#endif
#if PHM & 2
    { PHASE_IDS
    REP(2) { const float* x = ldarg(0); const float* ln1_g = ldarg(5);
    for (int ch = gw; ch < NT / 32; ch += NGW) {
        const int b = (ch * 32) >> 13;
        f32x4 cs[4], sh[4];
#pragma unroll
        for (int j = 0; j < 4; ++j) { const int c0 = 4 * lane + 256 * j; const f32x4 gg = *(const f32x4*)(ln1_g + c0), sc = *(const f32x4*)(MOD + b * 6144 + 1024 + c0);
            cs[j] = gg * (sc + 1.f); sh[j] = *(const f32x4*)(MOD + b * 6144 + c0); }
        for (int rr = 0; rr < 32; ++rr) {
            const size_t row = (size_t)ch * 32 + rr;
            const f32x4* xr = (const f32x4*)(x + row * 1024) + lane;
            f32x4 v[4]; float s = 0.f;
#pragma unroll
            for (int j = 0; j < 4; ++j) { v[j] = xr[64 * j]; s += dot4(v[j]); }
            const float rstd = __builtin_amdgcn_rsqf(wave_sum(s) * (1.f / 1024.f) + EPS);
            u32x2* o8 = (u32x2*)(H1 + row * 1024) + lane;
#pragma unroll
            for (int j = 0; j < 4; ++j) { const f32x4 y = v[j] * rstd * cs[j] + sh[j]; u32x2 w; w.x = pk2(y[0], y[1]); w.y = pk2(y[2], y[3]); o8[64 * j] = w; }
        }
    }
    }
    xcd_barrier(xbar);

    }
#endif
#if PHM & 4
    { PHASE_IDS
    REP(4) {
        pg8::Gemm g{H1, WT_in, 1024, 1024}; pg8::StaticOrder S; S.init(256, 5, G, bx, (size_t)256 * 1024 * 2, (size_t)256 * 1024 * 2);
        Epi1 E{Z, KR, UX, SSQ1, CS};
        pg8::gemm_phase(lds, g, S, E);
    }
    xcd_barrier(xbar);

    }
#endif
#if PHM & 8
    { PHASE_IDS
    REP(8) {
#if P3SEL & 1
        { pg8::Gemm g{Z, WT_uq, 384, 640}; pg8::StaticOrder S; S.init(256, 3, G, bx, (size_t)256 * 640 * 2, (size_t)256 * 384 * 2); EpiQ E{Qb, SSQ1, CS}; pg8::gemm_phase(lds, g, S, E); }
#endif
#if P3SEL & 2
        { pg8::Gemm g{Z + 384, WT_ukv, 256, 640}; pg8::StaticOrder S; S.init(256, 4, G, bx, (size_t)256 * 640 * 2, (size_t)256 * 256 * 2); EpiKV E{KN, VT, SSQ1}; pg8::gemm_phase(lds, g, S, E); }
#endif
#if P3SEL & 4
        for (int bg = bx; bg < 256; bg += G) { pg8::Gemm g{UX, WS5S, 256, 384}; pg8::BGOrder S{bg & 7, bg >> 3, (size_t)4096 * 384 * 2, (size_t)256 * 256 * 2, (size_t)256 * 384 * 2}; EpiS5a E{SB}; pg8::gemm_phase(lds, g, S, E); }
#endif
    }
    xcd_barrier(xbar);

    }
#endif
#if PHM & 16
    { PHASE_IDS
#if P4SEL & 1
    REP(16) for (int bg = bx; bg < 256; bg += G) {
        const int b = bg & 7, g = bg >> 3;
        {
            const int p = lane; const f32x2 A = A16[g * 64 + p];
            const float* sb = SB + ((size_t)g * 4096 + b * 512 + 64 * wid) * 128; bf16_t* ux = UX + ((size_t)g * 4096 + b * 512 + 64 * wid) * 384 + 256;
            LAS float* ex = (LAS float*)lds;
            float xr = 0.f, xi = 0.f;
            for (int c0 = 0; c0 < 64; c0 += 8) {
                float sr[8], si[8];
#pragma unroll
                for (int k = 0; k < 8; ++k) { sr[k] = sb[(size_t)(c0 + k) * 128 + p]; si[k] = sb[(size_t)(c0 + k) * 128 + 64 + p]; }
#pragma unroll
                for (int k = 0; k < 8; ++k) { const float nr = A.x * xr - A.y * xi + sr[k], ni = A.x * xi + A.y * xr + si[k]; xr = nr; xi = ni; }
            }
            ex[wid * 128 + p] = xr; ex[wid * 128 + 64 + p] = xi;
            __syncthreads();
            float ar = A.x, ai = A.y;
#pragma unroll
            for (int k = 0; k < 6; ++k) { const float nr = ar * ar - ai * ai, ni = 2.f * ar * ai; ar = nr; ai = ni; }
            xr = 0.f; xi = 0.f;
            for (int v = 0; v < wid; ++v) { const float er = ex[v * 128 + p], ei = ex[v * 128 + 64 + p]; const float nr = ar * xr - ai * xi + er, ni = ar * xi + ai * xr + ei; xr = nr; xi = ni; }
            for (int c0 = 0; c0 < 64; c0 += 8) {
                float sr[8], si[8];
#pragma unroll
                for (int k = 0; k < 8; ++k) { sr[k] = sb[(size_t)(c0 + k) * 128 + p]; si[k] = sb[(size_t)(c0 + k) * 128 + 64 + p]; }
#pragma unroll
                for (int k = 0; k < 8; ++k) {
                    ux[(size_t)(c0 + k) * 384 + p] = (bf16_t)(pk2(xr, 0.f) & 0xffffu); ux[(size_t)(c0 + k) * 384 + 64 + p] = (bf16_t)(pk2(xi, 0.f) & 0xffffu);
                    const float nr = A.x * xr - A.y * xi + sr[k], ni = A.x * xi + A.y * xr + si[k]; xr = nr; xi = ni;
                }
            }
        }
        blk_sync_mem();
        pg8::Gemm gm{UX, WS5T, 384, 384}; pg8::BGOrder S{b, g, (size_t)4096 * 384 * 2, (size_t)256 * 384 * 2, (size_t)256 * 384 * 2}; EpiS5c E{YSSM, UX, ldarg(18)};
        pg8::gemm_phase(lds, gm, S, E);
    }
#endif
    __syncthreads();
#if P4SEL & 2
    REP(32) for (int v = bx; v < 256; v += G) {
        const int vv = (v & 7) * 32 + (v >> 3);
        const int bh = vv >> 3, s = vv & 7;
#pragma unroll 1
        for (int i = 0; i < 4; ++i) { const int qb = (i == 0) ? s : (i == 1) ? 15 - s : (i == 2) ? 16 + s : 31 - s;
            att::attn_unit(bh >> 2, bh & 3, qb, Qb, KN, KR, VT, AS, ASSQ, lds); }
    }
#endif
    xcd_barrier(xbar);

    }
#endif
#if PHM & 32
    { PHASE_IDS
    REP(128) { pg8::Gemm g{YSSM, WT_glu, 512, 512}; pg8::StaticOrder S; S.init(256, 4, G, bx, (size_t)256 * 512 * 2, (size_t)256 * 512 * 2); EpiGLU E{AS, SSQ2, ldarg(20)}; pg8::gemm_phase(lds, g, S, E); }
    xcd_barrier(xbar);
    for (int row = bx * 512 + tid; row < NT; row += G * 512) {
        const f32x4 sa = *(const f32x4*)(ASSQ + (size_t)row * 4); const f32x4* sp = (const f32x4*)(SSQ2 + (size_t)row * 16);
        const float rsa = __builtin_amdgcn_rsqf(sum4(sa) * (1.f / 512.f) + EPS), rss = __builtin_amdgcn_rsqf((sum4(sp[0]) + sum4(sp[1]) + sum4(sp[2]) + sum4(sp[3])) * (1.f / 512.f) + EPS);
        RST[(size_t)row * 4] = rsa / rss; RST[(size_t)row * 4 + 1] = rss;
    }
    xcd_barrier(xbar);
    REP(128) { pg8::Gemm g{AS, WT_out, 1024, 1024}; pg8::StaticOrder S; S.init(256, 4, G, bx, (size_t)256 * 1024 * 2, (size_t)256 * 1024 * 2); EpiOut E{ldarg(0), out, MOD + 2048, SSQ3, RST}; pg8::gemm_phase(lds, g, S, E); }
    xcd_barrier(xbar);
    REP(512) for (int ch = gw; ch < NT / 32; ch += NGW) {
        const int b = (ch * 32) >> 13;
        f32x4 cs[4], sh[4];
#pragma unroll
        for (int j = 0; j < 4; ++j) { const int c0 = 4 * lane + 256 * j; const f32x4 gg = *(const f32x4*)(ldarg(24) + c0), sc = *(const f32x4*)(MOD + b * 6144 + 4096 + c0);
            cs[j] = gg * (sc + 1.f); sh[j] = *(const f32x4*)(MOD + b * 6144 + 3072 + c0); }
        for (int rr = 0; rr < 32; ++rr) {
            const size_t row = (size_t)ch * 32 + rr;
            const float rstd = __builtin_amdgcn_rsqf(wave_sum(SSQ3[row * 32 + (lane & 31)]) * (0.5f / 1024.f) + EPS);
            const f32x4* xr = (const f32x4*)(out + row * 1024) + lane; u32x2* o8 = (u32x2*)(H2 + row * 1024) + lane;
#pragma unroll
            for (int j = 0; j < 4; ++j) { const f32x4 y = xr[64 * j] * rstd * cs[j] + sh[j]; u32x2 w; w.x = pk2(y[0], y[1]); w.y = pk2(y[2], y[3]); o8[64 * j] = w; }
        }
    }
    xcd_barrier(xbar);

    }
#endif
#if PHM & 64
    { PHASE_IDS
    REP(64) {
        pg8::Gemm g{H2, WT_up, 1024, 1024}; pg8::StaticOrder S; S.init(256, 22, G, bx, (size_t)256 * 1024 * 2, (size_t)256 * 1024 * 2);
        EpiUp E{ACT, HALO, FIX, ldarg(26), ldarg(27)};
        pg8::gemm_phase(lds, g, S, E);
    }
    xcd_barrier(xbar);

    }
#endif
#if PHM & 128
    { PHASE_IDS
    for (int pm = bx; pm < 256; pm += G) {
        const float* conv_w = ldarg(26); const float* conv_b = ldarg(27);
        for (int it = tid; it < 4 * DFF; it += 512) {
            const int col = it % DFF, sj = it / DFF, wr = sj >> 1, jj = sj & 1;
            const float* f = FIX + ((size_t)(pm * 2 + wr) * 4) * DFF + col;
            const float g0 = f[0], v0 = f[DFF], g1 = f[2 * DFF], v1 = f[3 * DFF];
            float h6 = 0.f, h7 = 0.f;
            if (wr == 1) { const float* hp = HALO + ((size_t)(pm * 2) * 2) * DFF + col; h6 = hp[0]; h7 = hp[DFF]; }
            else if ((pm & 31) != 0) { const float* hp = HALO + ((size_t)((pm - 1) * 2 + 1) * 2) * DFF + col; h6 = hp[0]; h7 = hp[DFF]; }
            const float w0 = conv_w[col], w1 = conv_w[DFF + col], w2 = conv_w[2 * DFF + col], bb = conv_b[col];
            const float y = jj == 0 ? gelu_t(bb + w0 * h6 + w1 * h7 + w2 * g0) * v0 : gelu_t(bb + w0 * h7 + w1 * g0 + w2 * g1) * v1;
            ACT[((size_t)pm * 256 + 128 * wr + jj) * DFF + col] = (bf16_t)(pk2(y, 0.f) & 0xffffu);
        }
    }
    xcd_barrier(xbar);
    { pg8::Gemm g{ACT, WT_down, DFF, DFF}; pg8::StaticOrder S; S.init(256, 4, G, bx, (size_t)256 * DFF * 2, (size_t)256 * DFF * 2); EpiRes E{out, out, MOD + 5120, SSQ4}; pg8::gemm_phase(lds, g, S, E); }
    xcd_barrier(xbar);
    {
        f32x4 fg[4];
#pragma unroll
        for (int j = 0; j < 4; ++j) fg[j] = *(const f32x4*)(ldarg(29) + 4 * lane + 256 * j);
        for (int ch = gw; ch < NT / 32; ch += NGW)
            for (int rr = 0; rr < 32; ++rr) {
                const size_t row = (size_t)ch * 32 + rr;
                const float rstd = __builtin_amdgcn_rsqf(wave_sum(SSQ4[row * 32 + (lane & 31)]) * (0.5f / 1024.f) + EPS);
                f32x4* xr = (f32x4*)(out + row * 1024) + lane;
#pragma unroll
                for (int j = 0; j < 4; ++j) xr[64 * j] = xr[64 * j] * rstd * fg[j];
            }
    }
    }
#endif
}

extern "C" void kernel_launch(void* const* d_in, const int* in_sizes, int n_in, void* d_out, int out_size, void* d_ws, size_t ws_size, hipStream_t stream) {
    constexpr int LDSB = 147456;
    static int grid = 0;
    if (!grid) {
        if (n_in != 30 || out_size != NT * DM || ws_size < WS_END) { fprintf(stderr, "kernel_launch: unexpected problem (n_in %d out %d ws %zu need %zu)\n", n_in, out_size, ws_size, (size_t)WS_END); grid = -1; return; }
        int dev = 0, cus = 0, per = 0;
        (void)hipGetDevice(&dev);
        (void)hipDeviceGetAttribute(&cus, hipDeviceAttributeMultiprocessorCount, dev);
        (void)hipFuncSetAttribute((const void*)fwd_kernel, hipFuncAttributeMaxDynamicSharedMemorySize, LDSB);
        (void)hipOccupancyMaxActiveBlocksPerMultiprocessor(&per, (const void*)fwd_kernel, 512, LDSB);
        if (per < 1) per = 1;
        grid = cus * per; if (grid > 256) grid = 256;
    }
    if (grid < 0) return;
    (void)hipMemsetAsync((char*)d_ws + WS_BAR, 0, XCD_BAR_WORDS * 4, stream);
    Args a{};
    for (int i = 0; i < 30; ++i) a.in[i] = d_in[i];
    a.out = (float*)d_out; a.ws = (unsigned char*)d_ws;
    void* args[] = {&a};
    hipError_t e = hipLaunchCooperativeKernel((const void*)fwd_kernel, dim3(grid), dim3(512), args, LDSB, stream);
    if (e != hipSuccess) fprintf(stderr, "cooperative launch failed: %s (grid %d)\n", hipGetErrorString(e), grid);
}
```

```cpp
#include <hip/hip_runtime.h>
#include <hip/hip_cooperative_groups.h>
#include <cstdio>
#include <cstdint>
namespace cg = cooperative_groups;
#ifndef PHM
#define PHM 255
#endif
#ifndef ATT_SGB
#define ATT_SGB 0
#endif
#ifndef DBL
#define DBL 0
#endif
#define REP(bit) for (int rep_ = 0; rep_ < ((DBL & (bit)) ? 2 : 1); ++rep_)
#ifndef P3SEL
#define P3SEL 7
#endif
#ifndef P4SEL
#define P4SEL 3
#endif

#define LAS __attribute__((address_space(3)))
typedef unsigned short bf16_t;
typedef short bf16x8 __attribute__((ext_vector_type(8)));
typedef float f32x2 __attribute__((ext_vector_type(2)));
typedef float f32x4 __attribute__((ext_vector_type(4)));
typedef float f32x16 __attribute__((ext_vector_type(16)));
typedef unsigned u32x2 __attribute__((ext_vector_type(2)));
typedef unsigned u32x4 __attribute__((ext_vector_type(4)));
typedef __bf16 bf16x2_t __attribute__((ext_vector_type(2)));

constexpr int NB = 8, SEQ = 8192, DM = 1024, NT = NB * SEQ;
constexpr int NIN = 1216, NINP = 1280;
constexpr int DFF = 2816;
constexpr float EPS = 1e-6f;
constexpr float QSCALE = 0.07216878364870322f * 1.4426950408889634f;

constexpr size_t MiB = 1u << 20;
constexpr size_t WS_WIN = 0 * MiB;
constexpr size_t WS_WUQ = 3 * MiB;
constexpr size_t WS_WUKV = 4 * MiB;
constexpr size_t WS_WGLU = 5 * MiB;
constexpr size_t WS_WOUT = 6 * MiB;
constexpr size_t WS_WUP = 8 * MiB;
constexpr size_t WS_WDOWN = 19 * MiB;
constexpr size_t WS_WS5S = 25 * MiB;
constexpr size_t WS_WS5T = 29 * MiB;
constexpr size_t WS_MOD = 35 * MiB;
constexpr size_t WS_BAR = 35 * MiB + 768 * 1024;
constexpr size_t WS_CS = 36 * MiB;
constexpr size_t WS_SSQ1 = 52 * MiB;
constexpr size_t WS_ASSQ = 60 * MiB;
constexpr size_t WS_SSQ2 = 61 * MiB;
constexpr size_t WS_SSQ3 = 65 * MiB;
constexpr size_t WS_SSQ4 = 73 * MiB;
constexpr size_t WS_HALO = 81 * MiB;
constexpr size_t WS_FIX = 92 * MiB;
constexpr size_t WS_YSSM = 114 * MiB;
constexpr size_t WS_AS = 178 * MiB;
constexpr size_t WS_R1 = 306 * MiB;
constexpr size_t WS_H1 = WS_R1;
constexpr size_t WS_Z = WS_R1 + 128 * MiB;
constexpr size_t WS_UX = WS_R1 + 208 * MiB;
constexpr size_t WS_SB = WS_R1 + 304 * MiB;
constexpr size_t WS_Q = WS_R1 + 368 * MiB;
constexpr size_t WS_KN = WS_R1 + 464 * MiB;
constexpr size_t WS_VT = WS_R1 + 528 * MiB;
constexpr size_t WS_KR = WS_R1 + 592 * MiB;
constexpr size_t WS_RST = WS_R1 + 592 * MiB;
constexpr size_t WS_H2 = WS_R1;
constexpr size_t WS_ACT = WS_R1 + 128 * MiB;
constexpr size_t WS_END = WS_R1 + 600 * MiB;

__device__ __forceinline__ unsigned pk2(float lo, float hi) { f32x2 v = {lo, hi}; bf16x2_t b = __builtin_convertvector(v, bf16x2_t); return __builtin_bit_cast(unsigned, b); }
__device__ __forceinline__ u32x4 pack8(f32x4 a, f32x4 b) { u32x4 w; w.x = pk2(a[0], a[1]); w.y = pk2(a[2], a[3]); w.z = pk2(b[0], b[1]); w.w = pk2(b[2], b[3]); return w; }
__device__ __forceinline__ float bflo(unsigned w) { return __uint_as_float(w << 16); }
__device__ __forceinline__ float bfhi(unsigned w) { return __uint_as_float(w & 0xffff0000u); }
__device__ __forceinline__ float sum4(f32x4 v) { return (v[0] + v[1]) + (v[2] + v[3]); }
__device__ __forceinline__ float dot4(f32x4 v) { return (v[0] * v[0] + v[1] * v[1]) + (v[2] * v[2] + v[3] * v[3]); }
__device__ __forceinline__ float red_fq(float v) { v += __shfl_xor(v, 16); v += __shfl_xor(v, 32); return v; }
__device__ __forceinline__ float wave_sum(float v) {
#pragma unroll
    for (int o = 1; o < 64; o <<= 1) v += __shfl_xor(v, o);
    return v;
}
__device__ __forceinline__ float gelu_t(float x) {
    const float u = 0.7978845608028654f * (x + 0.044715f * x * x * x);
    const float e = __builtin_amdgcn_exp2f(-2.885390081777927f * u);
    return x * __builtin_amdgcn_rcpf(1.f + e);
}
__device__ __forceinline__ float sigmoid_f(float g) { return __builtin_amdgcn_rcpf(1.f + __builtin_amdgcn_exp2f(-1.4426950408889634f * g)); }
__device__ __forceinline__ void sincos_d(double ang, float& s, float& c) {
    double rv = ang * 0.15915494309189535; rv -= rint(rv); const float r = (float)(rv * 6.283185307179586);
    s = sinf(r); c = cosf(r);
}

namespace pg8 {
constexpr int BM = 256, BK = 64, HALF = 128, HTB = HALF * BK * 2, STAGE_BYTES = 8 * HTB, NXCD = 8, WGM = 4;
__host__ __device__ __forceinline__ int lds_byte(int r, int c) { const int st = (r >> 4) * 2 + (c >> 5), rr = r & 15, cc = c & 31, ob = rr * 64 + cc * 2; return st * 1024 + (ob ^ (((ob >> 9) & 1) << 5)); }
__host__ __device__ __forceinline__ void stage_rc(int b, int& R, int& C) { const int st = b / 1024, sb = b % 1024, swz = sb ^ (((sb >> 9) & 1) << 5); R = (st >> 1) * 16 + swz / 64; C = (st & 1) * 32 + (swz % 64) / 2; }
__host__ __device__ __forceinline__ int perm32(int rho) { const int n = rho >> 4, i = rho & 15; return 8 * (i >> 2) + 4 * n + (i & 3); }

struct Unit { int pm, pn, g; size_t aoff, boff; };
struct Gemm { const bf16_t* A; const bf16_t* Bt; int K; int lda; };

struct StaticOrder {
    int nM, nN, nwg, G, c; size_t tA, tB;
    __device__ void init(int nM_, int nN_, int G_, int c_, size_t tA_, size_t tB_) { nM = nM_; nN = nN_; nwg = nM * nN; G = G_; c = c_; tA = tA_; tB = tB_; }
    __device__ bool next(int i, Unit& u) const {
        const long L = (long)i * G + c; if (L >= nwg) return false;
        int wgid = (int)L; { const int q = nwg / NXCD, r = nwg % NXCD, xcd = wgid % NXCD, off = wgid / NXCD; wgid = (xcd < r ? xcd * (q + 1) : r * (q + 1) + (xcd - r) * q) + off; }
        const int nig = WGM * nN, gid = wgid / nig, fm = gid * WGM, gsz = (nM - fm) < WGM ? (nM - fm) : WGM;
        u.pm = fm + ((wgid % nig) % gsz); u.pn = (wgid % nig) / gsz; u.g = 0; u.aoff = (size_t)u.pm * tA; u.boff = (size_t)u.pn * tB; return true;
    }
};
struct GroupOrder {
    int G, c; size_t gA, gB, tA;
    __device__ bool next(int i, Unit& u) const { const long L = (long)i * G + c; if (L >= 512) return false; u.g = (int)(L >> 4); u.pm = (int)(L & 15); u.pn = 0; u.aoff = (size_t)u.g * gA + (size_t)u.pm * tA; u.boff = (size_t)u.g * gB; return true; }
};
struct PanelOrder {
    int pm, nN; size_t tA, tB;
    __device__ bool next(int i, Unit& u) const { if (i >= nN) return false; u.pm = pm; u.pn = i; u.g = 0; u.aoff = (size_t)pm * tA; u.boff = (size_t)i * tB; return true; }
};
struct BGOrder {
    int b, g; size_t gA, gB, tA;
    __device__ bool next(int i, Unit& u) const { if (i >= 2) return false; u.g = g; u.pm = 2 * b + i; u.pn = 0; u.aoff = (size_t)g * gA + (size_t)u.pm * tA; u.boff = (size_t)g * gB; return true; }
};

template <class Epi, class Sched>
__device__ __forceinline__ void gemm_phase(LAS unsigned char* lds, const Gemm g, const Sched& S, const Epi& E) {
    int tid_ = threadIdx.x; asm volatile("" : "+v"(tid_));
    const int tid = tid_, wid = __builtin_amdgcn_readfirstlane(tid >> 6), lane = tid & 63, wr = wid >> 2, wc = wid & 3, fr = lane & 15, fq = lane >> 4;
    int K_ = g.K; asm volatile("" : "+s"(K_));
    const int K = K_, nt = K / BK, lda = g.lda;
    unsigned voffA[2], voffB[2];
#pragma unroll
    for (int i = 0; i < 2; ++i) { int R, C; stage_rc(tid * 16 + i * 8192, R, C); const int Rb = Epi::PERM ? ((R & ~31) + perm32(R & 31)) : R;
        const int Ra = Epi::ROWPERM ? (8 * (16 * (R >> 6) + (R & 15)) + ((R >> 4) & 3)) : R;
        voffA[i] = (unsigned)(Ra * lda + C) * 2u; voffB[i] = (unsigned)(Rb * K + C) * 2u; }
    const size_t kstep = (size_t)(BK * 2);
    const size_t hstepA = (size_t)(Epi::ROWPERM ? 4 : HALF) * lda * 2;
    const size_t hstepB = (size_t)HALF * K * 2;
    const unsigned ldsw = (unsigned)wid * 1024u;
    const int aoff = lds_byte(wr * 64 + fr, fq * 8), boff = lds_byte(wc * 32 + fr, fq * 8);
#define PG8_SA(b, h) (((b) * 2 + (h)) * HTB)
#define PG8_SB(b, h) ((4 + (b) * 2 + (h)) * HTB)
#define PG8_STAGE(bufoff, gbase, voff) do { _Pragma("unroll") for (int _i = 0; _i < 2; ++_i) \
        __builtin_amdgcn_global_load_lds((const unsigned*)((const char*)(gbase) + (voff)[_i]), (LAS unsigned*)(lds + (bufoff) + ldsw + _i * 8192), 16, 0, 0); } while (0)
#define PG8_LDA(dst, b, h) do { _Pragma("unroll") for (int m = 0; m < 4; ++m) _Pragma("unroll") for (int k = 0; k < 2; ++k) dst[m][k] = *(const LAS bf16x8*)(lds + PG8_SA(b, h) + aoff + m * 2048 + k * 1024); } while (0)
#define PG8_LDB(dst, b, h) do { _Pragma("unroll") for (int n = 0; n < 2; ++n) _Pragma("unroll") for (int k = 0; k < 2; ++k) dst[n][k] = *(const LAS bf16x8*)(lds + PG8_SB(b, h) + boff + n * 2048 + k * 1024); } while (0)
#define PG8_MMA(ai, bj, At, Bt) do { __builtin_amdgcn_s_setprio(1); _Pragma("unroll") for (int m = 0; m < 4; ++m) _Pragma("unroll") for (int n = 0; n < 2; ++n) _Pragma("unroll") for (int k = 0; k < 2; ++k) \
        acc[ai][bj][m][n] = __builtin_amdgcn_mfma_f32_16x16x32_bf16(Bt[n][k], At[m][k], acc[ai][bj][m][n], 0, 0, 0); __builtin_amdgcn_s_setprio(0); } while (0)
#define PG8_WAIT_V(n) asm volatile("s_waitcnt vmcnt(" #n ")" ::: "memory")
#define PG8_WAIT_L(n) asm volatile("s_waitcnt lgkmcnt(" #n ")" ::: "memory")
#define PG8_BAR __builtin_amdgcn_s_barrier()
#define PG8_SCHED __builtin_amdgcn_sched_barrier(0)
    Unit cur, nxt; int ui = 0;
    if (!S.next(0, cur)) return;
    f32x4 acc[2][2][4][2];
#pragma unroll
    for (int a = 0; a < 2; ++a)
#pragma unroll
        for (int b = 0; b < 2; ++b)
#pragma unroll
            for (int m = 0; m < 4; ++m)
#pragma unroll
                for (int n = 0; n < 2; ++n) acc[a][b][m][n] = (f32x4){0.f, 0.f, 0.f, 0.f};
    bf16x8 At[4][2], B0[2][2], B1[2][2];
    const char* cA = (const char*)g.A + cur.aoff; const char* cB = (const char*)g.Bt + cur.boff;
    PG8_STAGE(PG8_SB(0, 0), cB, voffB); PG8_STAGE(PG8_SB(0, 1), cB + hstepB, voffB); PG8_STAGE(PG8_SA(0, 0), cA, voffA); PG8_STAGE(PG8_SA(0, 1), cA + hstepA, voffA);
    if (wr == 1) PG8_BAR;
    PG8_WAIT_V(2); PG8_BAR;
    PG8_STAGE(PG8_SB(1, 0), cB + kstep, voffB); PG8_STAGE(PG8_SA(1, 0), cA + kstep, voffA); PG8_STAGE(PG8_SB(1, 1), cB + hstepB + kstep, voffB);
    PG8_WAIT_V(6); PG8_BAR;
    for (;;) {
        const bool has_next = S.next(ui + 1, nxt);
        const char* nA = has_next ? (const char*)g.A + nxt.aoff : cA; const char* nB = has_next ? (const char*)g.Bt + nxt.boff : cB;
#pragma unroll 1
        for (int t = 0; t < nt; t += 2) {
            const bool last = (t == nt - 2);
            const char* a1 = cA + (size_t)(t + 1) * kstep;
            const char* a2 = last ? nA : cA + (size_t)(t + 2) * kstep; const char* b2 = last ? nB : cB + (size_t)(t + 2) * kstep;
            const char* a3 = a2 + kstep; const char* b3 = b2 + kstep;
            if constexpr (Epi::MIDK) { if (t == 8) E.mid(acc, cur, wr, wc, fr, fq); }
            PG8_LDB(B0, 0, 0); PG8_LDB(B1, 0, 1); PG8_SCHED; PG8_LDA(At, 0, 0); PG8_STAGE(PG8_SA(1, 1), a1 + hstepA, voffA);
            PG8_WAIT_V(8); PG8_WAIT_L(0); PG8_BAR; PG8_MMA(0, 0, At, B0); PG8_MMA(0, 1, At, B1); PG8_BAR; PG8_SCHED;
            PG8_LDA(At, 0, 1); PG8_STAGE(PG8_SB(0, 0), b2, voffB); PG8_STAGE(PG8_SB(0, 1), b2 + hstepB, voffB); PG8_STAGE(PG8_SA(0, 0), a2, voffA);
            PG8_WAIT_V(8); PG8_WAIT_L(0); PG8_BAR; PG8_MMA(1, 0, At, B0); PG8_MMA(1, 1, At, B1); PG8_BAR; PG8_SCHED;
            PG8_LDB(B0, 1, 0); PG8_LDB(B1, 1, 1); PG8_SCHED; PG8_LDA(At, 1, 0); PG8_STAGE(PG8_SA(0, 1), a2 + hstepA, voffA);
            PG8_WAIT_V(8); PG8_WAIT_L(0); PG8_BAR; PG8_MMA(0, 0, At, B0); PG8_MMA(0, 1, At, B1); PG8_BAR; PG8_SCHED;
            PG8_LDA(At, 1, 1); PG8_STAGE(PG8_SB(1, 0), b3, voffB); PG8_STAGE(PG8_SB(1, 1), b3 + hstepB, voffB); PG8_STAGE(PG8_SA(1, 0), a3, voffA);
            PG8_WAIT_V(8); PG8_WAIT_L(0); PG8_BAR; PG8_MMA(1, 0, At, B0); PG8_MMA(1, 1, At, B1); PG8_BAR; PG8_SCHED;
        }
        if (wr == 0) PG8_BAR;
        E(acc, cur, wr, wc, fr, fq);
        if (!has_next) break;
#pragma unroll
        for (int a = 0; a < 2; ++a)
#pragma unroll
            for (int b = 0; b < 2; ++b)
#pragma unroll
                for (int m = 0; m < 4; ++m)
#pragma unroll
                    for (int n = 0; n < 2; ++n) acc[a][b][m][n] = (f32x4){0.f, 0.f, 0.f, 0.f};
        cur = nxt; cA = nA; cB = nB; ++ui;
        if (wr == 1) PG8_BAR;
    }
    PG8_WAIT_V(0);
    PG8_BAR;
#undef PG8_SA
#undef PG8_SB
#undef PG8_STAGE
#undef PG8_LDA
#undef PG8_LDB
#undef PG8_MMA
#undef PG8_WAIT_V
#undef PG8_WAIT_L
#undef PG8_BAR
#undef PG8_SCHED
}
}
using pg8::Unit;
typedef f32x4 Acc[2][2][4][2];

struct Epi1 {
    static constexpr bool PERM = true, ROWPERM = false, MIDK = false;
    bf16_t* Z; bf16_t* KR; bf16_t* UX; float* SSQ; const f32x2* CS;
    __device__ __forceinline__ void operator()(const Acc& acc, const Unit& u, int wr, int wc, int fr, int fq) const {
        int rb = u.pm * 256 + wr * 64 + fr;
#pragma unroll
        for (int bj = 0; bj < 2; ++bj) {
            const int gc = u.pn * 256 + bj * 128 + wc * 32, c0 = gc + 8 * fq;
            if (gc >= NIN) continue;
#pragma unroll
            for (int ai = 0; ai < 2; ++ai)
#pragma unroll
                for (int m = 0; m < 4; ++m) {
                    asm volatile("" : "+v"(rb)); const int row = rb + ai * 128 + m * 16;
                    const f32x4 v0 = acc[ai][bj][m][0], v1 = acc[ai][bj][m][1];
                    if (gc < 640) {
                        *(u32x4*)(Z + (size_t)row * 640 + c0) = pack8(v0, v1);
                        const float ss = red_fq(dot4(v0) + dot4(v1));
                        if (fq == 0) SSQ[(size_t)row * 32 + (gc >> 5)] = ss;
                    } else if (gc < 704) {
                        const f32x2* cs = CS + (size_t)row * 32 + ((c0 - 640) >> 1);
                        const f32x2 t0 = cs[0], t1 = cs[1], t2 = cs[2], t3 = cs[3];
                        f32x4 o0, o1;
                        o0[0] = v0[0] * t0.x - v0[1] * t0.y; o0[1] = v0[0] * t0.y + v0[1] * t0.x;
                        o0[2] = v0[2] * t1.x - v0[3] * t1.y; o0[3] = v0[2] * t1.y + v0[3] * t1.x;
                        o1[0] = v1[0] * t2.x - v1[1] * t2.y; o1[1] = v1[0] * t2.y + v1[1] * t2.x;
                        o1[2] = v1[2] * t3.x - v1[3] * t3.y; o1[3] = v1[2] * t3.y + v1[3] * t3.x;
                        *(u32x4*)(KR + (size_t)row * 64 + (c0 - 640)) = pack8(o0, o1);
                    } else {
                        const int ch = c0 - 704, g = ch >> 4, h0 = ch & 15, b = row >> 13, t = row & 8191;
                        *(u32x4*)(UX + ((size_t)g * 4096 + b * 512 + (t >> 4)) * 384 + (t & 15) * 16 + h0) = pack8(v0, v1);
                    }
                    asm volatile("" ::: "memory");
                }
        }
    }
};
struct EpiQ {
    static constexpr bool PERM = true, ROWPERM = false, MIDK = false;
    bf16_t* Q; const float* SSQ; const f32x2* CS;
    __device__ __forceinline__ void operator()(const Acc& acc, const Unit& u, int wr, int wc, int fr, int fq) const {
        int rb = u.pm * 256 + wr * 64 + fr;
#pragma unroll
        for (int ai = 0; ai < 2; ++ai)
#pragma unroll
            for (int m = 0; m < 4; ++m) {
                asm volatile("" : "+v"(rb)); const int row = rb + ai * 128 + m * 16;
                const f32x4* sp = (const f32x4*)(SSQ + (size_t)row * 32);
                const float rs = __builtin_amdgcn_rsqf((sum4(sp[0]) + sum4(sp[1]) + sum4(sp[2])) * (1.f / 384.f) + EPS) * QSCALE;
#pragma unroll
                for (int bj = 0; bj < 2; ++bj) {
                    const int gc = u.pn * 256 + bj * 128 + wc * 32, c0 = gc + 8 * fq, w = gc % 192;
                    f32x4 v0 = acc[ai][bj][m][0] * rs, v1 = acc[ai][bj][m][1] * rs;
                    if (w >= 128) {
                        const f32x2* cs = CS + (size_t)row * 32 + ((w - 128 + 8 * fq) >> 1);
                        const f32x2 t0 = cs[0], t1 = cs[1], t2 = cs[2], t3 = cs[3];
                        f32x4 o0, o1;
                        o0[0] = v0[0] * t0.x - v0[1] * t0.y; o0[1] = v0[0] * t0.y + v0[1] * t0.x;
                        o0[2] = v0[2] * t1.x - v0[3] * t1.y; o0[3] = v0[2] * t1.y + v0[3] * t1.x;
                        o1[0] = v1[0] * t2.x - v1[1] * t2.y; o1[1] = v1[0] * t2.y + v1[1] * t2.x;
                        o1[2] = v1[2] * t3.x - v1[3] * t3.y; o1[3] = v1[2] * t3.y + v1[3] * t3.x;
                        v0 = o0; v1 = o1;
                    }
                    *(u32x4*)(Q + (size_t)row * 768 + c0) = pack8(v0, v1);
                }
                asm volatile("" ::: "memory");
            }
    }
};
struct EpiKV {
    static constexpr bool PERM = true, ROWPERM = true, MIDK = false;
    bf16_t* KN; bf16_t* VT; const float* SSQ;
    __device__ __forceinline__ void operator()(const Acc& acc, const Unit& u, int wr, int wc, int fr, int fq) const {
        int tok0 = u.pm * 256 + 8 * (16 * wr + fr); const int h = u.pn;
        float rs[8];
#pragma unroll
        for (int j = 0; j < 8; ++j) { asm volatile("" : "+v"(tok0)); const f32x4* sp = (const f32x4*)(SSQ + (size_t)(tok0 + j) * 32 + 12); rs[j] = __builtin_amdgcn_rsqf((sum4(sp[0]) + sum4(sp[1])) * (1.f / 256.f) + EPS); }
        const int c0 = wc * 32 + 8 * fq;
#pragma unroll
        for (int ai = 0; ai < 2; ++ai)
#pragma unroll
            for (int m = 0; m < 4; ++m) { const int j = 4 * ai + m; asm volatile("" : "+v"(tok0));
                *(u32x4*)(KN + (size_t)(tok0 + j) * 512 + h * 128 + c0) = pack8(acc[ai][0][m][0] * rs[j], acc[ai][0][m][1] * rs[j]); asm volatile("" ::: "memory"); }
        const int b = tok0 >> 13, t0 = tok0 & 8191;
        bf16_t* vb = VT + ((size_t)(b * 4 + h) * 128 + c0) * 8192 + t0;
#pragma unroll
        for (int e = 0; e < 8; ++e) {
            const int n = e >> 2, k = e & 3; u32x4 w;
            w.x = pk2(acc[0][1][0][n][k] * rs[0], acc[0][1][1][n][k] * rs[1]); w.y = pk2(acc[0][1][2][n][k] * rs[2], acc[0][1][3][n][k] * rs[3]);
            w.z = pk2(acc[1][1][0][n][k] * rs[4], acc[1][1][1][n][k] * rs[5]); w.w = pk2(acc[1][1][2][n][k] * rs[6], acc[1][1][3][n][k] * rs[7]);
            *(u32x4*)(vb + (size_t)e * 8192) = w; asm volatile("" ::: "memory");
        }
    }
};
struct EpiS5a {
    static constexpr bool PERM = true, ROWPERM = false, MIDK = false;
    float* SB;
    __device__ __forceinline__ void operator()(const Acc& acc, const Unit& u, int wr, int wc, int fr, int fq) const {
        int rb = u.pm * 256 + wr * 64 + fr;
#pragma unroll
        for (int ai = 0; ai < 2; ++ai)
#pragma unroll
            for (int m = 0; m < 4; ++m) {
                asm volatile("" : "+v"(rb)); const int row = rb + ai * 128 + m * 16;
                float* p = SB + ((size_t)u.g * 4096 + row) * 128 + wc * 32 + 8 * fq;
                *(f32x4*)p = acc[ai][0][m][0]; *(f32x4*)(p + 4) = acc[ai][0][m][1];
            }
    }
};
struct EpiS5c {
    static constexpr bool PERM = true, ROWPERM = false, MIDK = false;
    bf16_t* Y; const bf16_t* UX; const float* Dk;
    __device__ __forceinline__ void operator()(const Acc& acc, const Unit& u, int wr, int wc, int fr, int fq) const {
        int rb = u.pm * 256 + wr * 64 + fr;
#pragma unroll
        for (int bj = 0; bj < 2; ++bj) {
            const int n0 = bj * 128 + wc * 32 + 8 * fq, i = n0 >> 4, h0 = n0 & 15;
#pragma unroll
            for (int ai = 0; ai < 2; ++ai)
#pragma unroll
                for (int m = 0; m < 4; ++m) {
                    asm volatile("" : "+v"(rb)); const int row = rb + ai * 128 + m * 16;
                    const u32x4 uu = *(const u32x4*)(UX + ((size_t)u.g * 4096 + row) * 384 + n0);
                    const f32x4 d0 = *(const f32x4*)(Dk + u.g * 16 + h0), d1 = *(const f32x4*)(Dk + u.g * 16 + h0 + 4);
                    f32x4 y0 = acc[ai][bj][m][0], y1 = acc[ai][bj][m][1];
                    y0[0] += d0[0] * bflo(uu.x); y0[1] += d0[1] * bfhi(uu.x); y0[2] += d0[2] * bflo(uu.y); y0[3] += d0[3] * bfhi(uu.y);
                    y1[0] += d1[0] * bflo(uu.z); y1[1] += d1[1] * bfhi(uu.z); y1[2] += d1[2] * bflo(uu.w); y1[3] += d1[3] * bfhi(uu.w);
#pragma unroll
                    for (int k = 0; k < 4; ++k) { y0[k] = gelu_t(y0[k]); y1[k] = gelu_t(y1[k]); }
                    const size_t tok = (size_t)(row >> 9) * 8192 + (size_t)(row & 511) * 16 + i;
                    *(u32x4*)(Y + tok * 512 + u.g * 16 + h0) = pack8(y0, y1); asm volatile("" ::: "memory");
                }
        }
    }
};
struct EpiGLU {
    static constexpr bool PERM = true, ROWPERM = false, MIDK = false;
    bf16_t* AS; float* SSQ; const float* bias;
    __device__ __forceinline__ void operator()(const Acc& acc, const Unit& u, int wr, int wc, int fr, int fq) const {
        int rb = u.pm * 256 + wr * 64 + fr;
        const int sc = u.pn * 128 + wc * 32 + 8 * fq;
        const f32x4 bv0 = *(const f32x4*)(bias + sc), bv1 = *(const f32x4*)(bias + sc + 4), bg0 = *(const f32x4*)(bias + 512 + sc), bg1 = *(const f32x4*)(bias + 512 + sc + 4);
#pragma unroll
        for (int ai = 0; ai < 2; ++ai)
#pragma unroll
            for (int m = 0; m < 4; ++m) {
                asm volatile("" : "+v"(rb)); const int row = rb + ai * 128 + m * 16;
                f32x4 o0, o1;
#pragma unroll
                for (int k = 0; k < 4; ++k) { o0[k] = (acc[ai][0][m][0][k] + bv0[k]) * sigmoid_f(acc[ai][1][m][0][k] + bg0[k]); o1[k] = (acc[ai][0][m][1][k] + bv1[k]) * sigmoid_f(acc[ai][1][m][1][k] + bg1[k]); }
                *(u32x4*)(AS + (size_t)row * 1024 + 512 + sc) = pack8(o0, o1);
                const float ss = red_fq(dot4(o0) + dot4(o1));
                if (fq == 0) SSQ[(size_t)row * 16 + u.pn * 4 + wc] = ss; asm volatile("" ::: "memory");
            }
    }
};
struct EpiRes {
    static constexpr bool PERM = true, ROWPERM = false, MIDK = false;
    const float* base; float* out; const float* gate; float* SSQ;
    __device__ __forceinline__ void operator()(const Acc& acc, const Unit& u, int wr, int wc, int fr, int fq) const {
        int rb = u.pm * 256 + wr * 64 + fr;
        const int b = u.pm >> 5;
#pragma unroll
        for (int bj = 0; bj < 2; ++bj) {
            const int c0 = u.pn * 256 + bj * 128 + wc * 32 + 8 * fq;
            const f32x4 g0 = *(const f32x4*)(gate + b * 6144 + c0), g1 = *(const f32x4*)(gate + b * 6144 + c0 + 4);
#pragma unroll
            for (int ai = 0; ai < 2; ++ai)
#pragma unroll
                for (int m = 0; m < 4; ++m) {
                    asm volatile("" : "+v"(rb)); const int row = rb + ai * 128 + m * 16;
                    const size_t off = (size_t)row * 1024 + c0;
                    const f32x4 x0 = *(const f32x4*)(base + off), x1 = *(const f32x4*)(base + off + 4);
                    const f32x4 o0 = x0 + g0 * acc[ai][bj][m][0], o1 = x1 + g1 * acc[ai][bj][m][1];
                    *(f32x4*)(out + off) = o0; *(f32x4*)(out + off + 4) = o1;
                    const float ss = red_fq(dot4(o0) + dot4(o1));
                    if (fq == 0) SSQ[(size_t)row * 32 + u.pn * 8 + bj * 4 + wc] = ss; asm volatile("" ::: "memory");
                }
        }
    }
};
struct EpiOut {
    static constexpr bool PERM = true, ROWPERM = false, MIDK = true;
    const float* base; float* out; const float* gate; float* SSQ; const float* RST;
    __device__ __forceinline__ void mid(Acc& acc, const Unit& u, int wr, int wc, int fr, int fq) const {
        int rb = u.pm * 256 + wr * 64 + fr;
#pragma unroll
        for (int ai = 0; ai < 2; ++ai)
#pragma unroll
            for (int m = 0; m < 4; ++m) {
                asm volatile("" : "+v"(rb)); const float r = RST[(size_t)(rb + ai * 128 + m * 16) * 4];
                acc[ai][0][m][0] *= r; acc[ai][0][m][1] *= r; acc[ai][1][m][0] *= r; acc[ai][1][m][1] *= r;
            }
    }
    __device__ __forceinline__ void operator()(const Acc& acc, const Unit& u, int wr, int wc, int fr, int fq) const {
        int rb = u.pm * 256 + wr * 64 + fr;
        const int b = u.pm >> 5;
#pragma unroll
        for (int bj = 0; bj < 2; ++bj) {
            const int c0 = u.pn * 256 + bj * 128 + wc * 32 + 8 * fq;
            const f32x4 g0 = *(const f32x4*)(gate + b * 6144 + c0), g1 = *(const f32x4*)(gate + b * 6144 + c0 + 4);
#pragma unroll
            for (int ai = 0; ai < 2; ++ai)
#pragma unroll
                for (int m = 0; m < 4; ++m) {
                    asm volatile("" : "+v"(rb)); const int row = rb + ai * 128 + m * 16;
                    const size_t off = (size_t)row * 1024 + c0;
                    const float rss = RST[(size_t)row * 4 + 1];
                    const f32x4 x0 = *(const f32x4*)(base + off), x1 = *(const f32x4*)(base + off + 4);
                    const f32x4 o0 = x0 + g0 * (acc[ai][bj][m][0] * rss), o1 = x1 + g1 * (acc[ai][bj][m][1] * rss);
                    *(f32x4*)(out + off) = o0; *(f32x4*)(out + off + 4) = o1;
                    const float ss = red_fq(dot4(o0) + dot4(o1));
                    if (fq == 0) SSQ[(size_t)row * 32 + u.pn * 8 + bj * 4 + wc] = ss; asm volatile("" ::: "memory");
                }
        }
    }
};
struct EpiDownNorm {
    static constexpr bool PERM = true, ROWPERM = false, MIDK = false;
    const float* base; float* out; const float* gate; const float* fg; unsigned* xs; unsigned* cnt; LAS unsigned char* l2;
    __device__ __forceinline__ void operator()(Acc& acc, const Unit& u, int wr, int wc, int fr, int fq) const {
        const int b = u.pm >> 5, lane = fq * 16 + fr, wid = wr * 4 + wc;
        LAS float* P = (LAS float*)l2; LAS float* S = (LAS float*)(l2 + 4096); LAS unsigned* flag = (LAS unsigned*)(l2 + 5120);
        int rb = u.pm * 256 + wr * 64 + fr;
#pragma unroll
        for (int ai = 0; ai < 2; ++ai)
#pragma unroll
            for (int m = 0; m < 4; ++m) {
                asm volatile("" : "+v"(rb)); const int row = rb + ai * 128 + m * 16;
                float s = 0.f;
#pragma unroll
                for (int bj = 0; bj < 2; ++bj) {
                    const int c0 = u.pn * 256 + bj * 128 + wc * 32 + 8 * fq; const size_t off = (size_t)row * 1024 + c0;
                    const f32x4 g0 = *(const f32x4*)(gate + b * 6144 + c0), g1 = *(const f32x4*)(gate + b * 6144 + c0 + 4);
                    const f32x4 x0 = *(const f32x4*)(base + off), x1 = *(const f32x4*)(base + off + 4);
                    acc[ai][bj][m][0] = x0 + g0 * acc[ai][bj][m][0]; acc[ai][bj][m][1] = x1 + g1 * acc[ai][bj][m][1];
                    s += dot4(acc[ai][bj][m][0]) + dot4(acc[ai][bj][m][1]);
                }
                s = red_fq(s);
                if (fq == 0) P[(ai * 128 + wr * 64 + m * 16 + fr) * 4 + wc] = s;
                asm volatile("" ::: "memory");
            }
        asm volatile("s_waitcnt lgkmcnt(0)" ::: "memory"); __builtin_amdgcn_s_barrier(); asm volatile("" ::: "memory");
        const int prow = wid * 32 + (lane & 31);
        if (lane < 32) {
            const float tot = (P[prow * 4] + P[prow * 4 + 1]) + (P[prow * 4 + 2] + P[prow * 4 + 3]);
            __hip_atomic_store(xs + ((size_t)(u.pm * 256 + prow)) * 4 + u.pn, __float_as_uint(tot), __ATOMIC_RELAXED, __HIP_MEMORY_SCOPE_AGENT);
        }
        asm volatile("s_waitcnt vmcnt(0)" ::: "memory");
        if (lane == 0) __hip_atomic_fetch_add(cnt + 64 * u.pm, 1u, __ATOMIC_RELAXED, __HIP_MEMORY_SCOPE_AGENT);
        if (wid == 0) {
            unsigned spins = 0; bool dead = false;
            for (;;) {
                if ((unsigned)__builtin_amdgcn_readfirstlane(__hip_atomic_load(cnt + 64 * u.pm, __ATOMIC_RELAXED, __HIP_MEMORY_SCOPE_AGENT)) >= 32u) break;
                __builtin_amdgcn_s_sleep(2);
                if (++spins > (1u << 20)) { dead = true; break; }
            }
            __builtin_amdgcn_fence(__ATOMIC_ACQUIRE, "agent");
            if (lane == 0) flag[0] = dead ? 1u : 0u;
        }
        asm volatile("s_waitcnt vmcnt(0) lgkmcnt(0)" ::: "memory"); __builtin_amdgcn_s_barrier(); asm volatile("" ::: "memory");
        if (lane < 32) {
            const unsigned* sl = xs + ((size_t)(u.pm * 256 + prow)) * 4;
            float t = 0.f;
#pragma unroll
            for (int k = 0; k < 4; ++k) t += __uint_as_float(__hip_atomic_load(sl + k, __ATOMIC_RELAXED, __HIP_MEMORY_SCOPE_AGENT));
            S[prow] = __builtin_amdgcn_rsqf(t * (1.f / 1024.f) + EPS);
        }
        asm volatile("s_waitcnt vmcnt(0) lgkmcnt(0)" ::: "memory"); __builtin_amdgcn_s_barrier(); asm volatile("" ::: "memory");
        const float poison = flag[0] ? __builtin_nanf("") : 1.f;
        rb = u.pm * 256 + wr * 64 + fr;
#pragma unroll
        for (int ai = 0; ai < 2; ++ai)
#pragma unroll
            for (int m = 0; m < 4; ++m) {
                asm volatile("" : "+v"(rb)); const int row = rb + ai * 128 + m * 16;
                const float rs = S[ai * 128 + wr * 64 + m * 16 + fr] * poison;
#pragma unroll
                for (int bj = 0; bj < 2; ++bj) {
                    const int c0 = u.pn * 256 + bj * 128 + wc * 32 + 8 * fq; const size_t off = (size_t)row * 1024 + c0;
                    const f32x4 f0 = *(const f32x4*)(fg + c0), f1 = *(const f32x4*)(fg + c0 + 4);
                    *(f32x4*)(out + off) = acc[ai][bj][m][0] * rs * f0; *(f32x4*)(out + off + 4) = acc[ai][bj][m][1] * rs * f1;
                }
                asm volatile("" ::: "memory");
            }
        asm volatile("s_waitcnt lgkmcnt(0)" ::: "memory"); __builtin_amdgcn_s_barrier(); asm volatile("" ::: "memory");
    }
};
struct EpiUp {
    static constexpr bool PERM = true, ROWPERM = true, MIDK = false;
    bf16_t* ACT; float* HALO; float* FIX; const float* cw; const float* cb;
    __device__ __forceinline__ void operator()(const Acc& acc, const Unit& u, int wr, int wc, int fr, int fq) const {
        const int tok0 = u.pm * 256 + 8 * (16 * wr + fr), cg0 = u.pn * 128 + wc * 32 + 8 * fq;
        unsigned pk[8][4];
#pragma unroll
        for (int pp = 0; pp < 4; ++pp) {
            float a2[2][8];
#pragma unroll
            for (int q = 0; q < 2; ++q) {
                const int e = 2 * pp + q, n = e >> 2, k = e & 3, col = cg0 + e;
                const float w0 = cw[col], w1 = cw[DFF + col], w2 = cw[2 * DFF + col], bb = cb[col];
                float g[8], v[8];
#pragma unroll
                for (int j = 0; j < 8; ++j) { g[j] = acc[j >> 2][0][j & 3][n][k]; v[j] = acc[j >> 2][1][j & 3][n][k]; }
                const float p7 = __int_as_float(__builtin_amdgcn_update_dpp(__float_as_int(g[7]), __float_as_int(g[7]), 0x111, 0xf, 0xf, false)),
                            p6 = __int_as_float(__builtin_amdgcn_update_dpp(__float_as_int(g[6]), __float_as_int(g[6]), 0x111, 0xf, 0xf, false));
                a2[q][0] = gelu_t(bb + w0 * p6 + w1 * p7 + w2 * g[0]) * v[0];
                a2[q][1] = gelu_t(bb + w0 * p7 + w1 * g[0] + w2 * g[1]) * v[1];
#pragma unroll
                for (int j = 2; j < 8; ++j) a2[q][j] = gelu_t(bb + w0 * g[j - 2] + w1 * g[j - 1] + w2 * g[j]) * v[j];
                if (fr == 0) { float* f = FIX + ((size_t)(u.pm * 2 + wr) * 4) * DFF + col; f[0] = g[0]; f[DFF] = v[0]; f[2 * DFF] = g[1]; f[3 * DFF] = v[1]; }
                if (fr == 15) { float* hp = HALO + ((size_t)(u.pm * 2 + wr) * 2) * DFF + col; hp[0] = g[6]; hp[DFF] = g[7]; }
            }
#pragma unroll
            for (int j = 0; j < 8; ++j) pk[j][pp] = pk2(a2[0][j], a2[1][j]);
        }
#pragma unroll
        for (int j = 0; j < 8; ++j) {
            if (j < 2 && fr == 0) continue;
            u32x4 w; w.x = pk[j][0]; w.y = pk[j][1]; w.z = pk[j][2]; w.w = pk[j][3];
            *(u32x4*)(ACT + (size_t)(tok0 + j) * DFF + cg0) = w;
        }
    }
};

namespace att {
constexpr int KROW = 400, VROW = 144, KBUF = 64 * KROW, VBUF = 128 * VROW, OFF_V = 2 * KBUF, LDS_BYTES = OFF_V + 2 * VBUF;
__device__ __forceinline__ void attn_unit(int b, int h, int qb, const bf16_t* __restrict__ Q, const bf16_t* __restrict__ KN, const bf16_t* __restrict__ KR, const bf16_t* __restrict__ VT,
                                          bf16_t* AS, float* ASSQ, LAS unsigned char* lds) {
    int tid_ = threadIdx.x; asm volatile("" : "+v"(tid_));
    const int tid = tid_, lane = tid & 63, wid = __builtin_amdgcn_readfirstlane(tid >> 6), q = lane & 31, hi = lane >> 5;
    const size_t tokb = (size_t)b * 8192;
    const int qrel = wid * 32 + q, qrow = qb * 256 + qrel;
    bf16x8 qf[12];
    { const bf16_t* qp = Q + (tokb + qrow) * 768 + h * 192 + hi * 8;
#pragma unroll
      for (int s = 0; s < 12; ++s) qf[s] = *(const bf16x8*)(qp + s * 16); }
    const bf16_t* ksrc[3]; int kstr[3]; unsigned kdst[3];
#pragma unroll
    for (int i = 0; i < 3; ++i) { const int p = tid + 512 * i, key = p / 24, pc = p % 24;
        if (pc < 16) { ksrc[i] = KN + (tokb + key) * 512 + h * 128 + pc * 8; kstr[i] = 64 * 512; } else { ksrc[i] = KR + (tokb + key) * 64 + (pc - 16) * 8; kstr[i] = 64 * 64; }
        kdst[i] = (unsigned)(key * KROW + pc * 16); }
    const bf16_t* vsrc[2]; unsigned vdst[2];
#pragma unroll
    for (int i = 0; i < 2; ++i) { const int p = tid + 512 * i, dv = p >> 3, pc = p & 7; vsrc[i] = VT + ((size_t)(b * 4 + h) * 128 + dv) * 8192 + pc * 8; vdst[i] = (unsigned)(OFF_V + dv * VROW + pc * 16); }
    const int ntile = 4 * (qb + 1);
    u32x4 st[5];
#define ATT_LOAD(t) do { _Pragma("unroll") for (int i = 0; i < 3; ++i) st[i] = *(const u32x4*)(ksrc[i] + (size_t)(t) * kstr[i]); \
                         _Pragma("unroll") for (int i = 0; i < 2; ++i) st[3 + i] = *(const u32x4*)(vsrc[i] + (size_t)(t) * 64); } while (0)
#define ATT_WRITE(buf) do { _Pragma("unroll") for (int i = 0; i < 3; ++i) *(LAS u32x4*)(lds + (buf) * KBUF + kdst[i]) = st[i]; \
                            _Pragma("unroll") for (int i = 0; i < 2; ++i) *(LAS u32x4*)(lds + (buf) * VBUF + vdst[i]) = st[3 + i]; } while (0)
    ATT_LOAD(0); ATT_WRITE(0);
    const int i16 = q & 15;
    const int krow = 16 * (q >> 4) + 8 * ((i16 >> 2) & 1) + (i16 & 3) + 4 * (i16 >> 3);
    const unsigned kaddr = (unsigned)(krow * KROW + hi * 16), vaddr = (unsigned)(OFF_V + q * VROW + hi * 16);
    float mrun = 0.f, lrun = 0.f;
    f32x16 o[4], negm;
#pragma unroll
    for (int r = 0; r < 16; ++r) negm[r] = 0.f;
#pragma unroll
    for (int k = 0; k < 4; ++k)
#pragma unroll
        for (int r = 0; r < 16; ++r) o[k][r] = 0.f;
    for (int t = 0; t < ntile; ++t) {
        if (t + 1 < ntile) ATT_LOAD(t + 1);
        __syncthreads();
        const int jb = t - (ntile - 4);
        if (!(jb >= 0 && 64 * jb > 32 * wid + 31)) {
            const unsigned kb = (unsigned)((t & 1) * KBUF) + kaddr, vb = (unsigned)((t & 1) * VBUF) + vaddr;
            f32x16 p0, p1;
            __builtin_amdgcn_s_setprio(1);
            { const bf16x8 a0 = *(const LAS bf16x8*)(lds + kb), a1 = *(const LAS bf16x8*)(lds + kb + 32 * KROW);
              p0 = __builtin_amdgcn_mfma_f32_32x32x16_bf16(a0, qf[0], negm, 0, 0, 0);
              p1 = __builtin_amdgcn_mfma_f32_32x32x16_bf16(a1, qf[0], negm, 0, 0, 0); }
#pragma unroll
            for (int s = 1; s < 12; ++s) {
                const bf16x8 a0 = *(const LAS bf16x8*)(lds + kb + s * 32), a1 = *(const LAS bf16x8*)(lds + kb + 32 * KROW + s * 32);
                p0 = __builtin_amdgcn_mfma_f32_32x32x16_bf16(a0, qf[s], p0, 0, 0, 0);
                p1 = __builtin_amdgcn_mfma_f32_32x32x16_bf16(a1, qf[s], p1, 0, 0, 0);
            }
            __builtin_amdgcn_s_setprio(0);
            if (jb >= 0) {
#pragma unroll
                for (int r = 0; r < 16; ++r) { const int kp = 64 * jb + 16 * (r >> 3) + 8 * hi + (r & 7);
                    if (kp > qrel) p0[r] = -INFINITY; if (kp + 32 > qrel) p1[r] = -INFINITY; }
            }
            float mx, mx2;
            asm("v_max3_f32 %0, %1, %2, %3" : "=v"(mx) : "v"(p0[0]), "v"(p1[0]), "v"(p0[1]));
            asm("v_max3_f32 %0, %1, %2, %3" : "=v"(mx2) : "v"(p1[1]), "v"(p0[2]), "v"(p1[2]));
#pragma unroll
            for (int r = 3; r < 15; r += 2) { asm("v_max3_f32 %0, %1, %2, %3" : "=v"(mx) : "v"(mx), "v"(p0[r]), "v"(p1[r])); asm("v_max3_f32 %0, %1, %2, %3" : "=v"(mx2) : "v"(mx2), "v"(p0[r + 1]), "v"(p1[r + 1])); }
            asm("v_max3_f32 %0, %1, %2, %3" : "=v"(mx) : "v"(mx), "v"(p0[15]), "v"(p1[15]));
            mx = fmaxf(mx, mx2);
            mx = fmaxf(mx, __shfl_xor(mx, 32));
            if (t == 0) {
                mrun = mx;
#pragma unroll
                for (int r = 0; r < 16; ++r) { p0[r] -= mx; p1[r] -= mx; negm[r] = -mx; }
            } else if (__any(mx > 8.f)) {
                const float d = fmaxf(mx, 0.f), f = __builtin_amdgcn_exp2f(-d);
                mrun += d; lrun *= f;
#pragma unroll
                for (int r = 0; r < 16; ++r) { p0[r] -= d; p1[r] -= d; negm[r] = -mrun; }
#pragma unroll
                for (int k = 0; k < 4; ++k)
#pragma unroll
                    for (int r = 0; r < 16; ++r) o[k][r] *= f;
            }
            float rs = 0.f, rs2 = 0.f, one = 1.f;
            asm volatile("" : "+v"(one));
#pragma unroll
            for (int r = 0; r < 16; ++r) { p0[r] = __builtin_amdgcn_exp2f(p0[r]); p1[r] = __builtin_amdgcn_exp2f(p1[r]); rs = __builtin_fmaf(p0[r], one, rs); rs2 = __builtin_fmaf(p1[r], one, rs2); }
            lrun += rs + rs2;
            bf16x8 pb[4];
            { u32x4 w;
              w.x = pk2(p0[0], p0[1]); w.y = pk2(p0[2], p0[3]); w.z = pk2(p0[4], p0[5]); w.w = pk2(p0[6], p0[7]); pb[0] = __builtin_bit_cast(bf16x8, w);
              w.x = pk2(p0[8], p0[9]); w.y = pk2(p0[10], p0[11]); w.z = pk2(p0[12], p0[13]); w.w = pk2(p0[14], p0[15]); pb[1] = __builtin_bit_cast(bf16x8, w);
              w.x = pk2(p1[0], p1[1]); w.y = pk2(p1[2], p1[3]); w.z = pk2(p1[4], p1[5]); w.w = pk2(p1[6], p1[7]); pb[2] = __builtin_bit_cast(bf16x8, w);
              w.x = pk2(p1[8], p1[9]); w.y = pk2(p1[10], p1[11]); w.z = pk2(p1[12], p1[13]); w.w = pk2(p1[14], p1[15]); pb[3] = __builtin_bit_cast(bf16x8, w); }
            __builtin_amdgcn_s_setprio(1);
#pragma unroll
            for (int k = 0; k < 4; ++k)
#pragma unroll
                for (int ks = 0; ks < 4; ++ks) {
                    const bf16x8 va = *(const LAS bf16x8*)(lds + vb + k * 32 * VROW + ks * 32);
                    o[k] = __builtin_amdgcn_mfma_f32_32x32x16_bf16(va, pb[ks], o[k], 0, 0, 0);
                }
            __builtin_amdgcn_s_setprio(0);
        }
        if (t + 1 < ntile) ATT_WRITE((t + 1) & 1);
    }
#undef ATT_LOAD
#undef ATT_WRITE
    const float ltot = lrun + __shfl_xor(lrun, 32), inv = 1.f / ltot;
    float ss = 0.f;
    bf16_t* op = AS + (tokb + qrow) * 1024 + h * 128 + 4 * hi;
#pragma unroll
    for (int k = 0; k < 4; ++k)
#pragma unroll
        for (int rg = 0; rg < 4; ++rg) {
            const float v0 = o[k][4 * rg] * inv, v1 = o[k][4 * rg + 1] * inv, v2 = o[k][4 * rg + 2] * inv, v3 = o[k][4 * rg + 3] * inv;
            ss += (v0 * v0 + v1 * v1) + (v2 * v2 + v3 * v3);
            u32x2 w; w.x = pk2(v0, v1); w.y = pk2(v2, v3);
            *(u32x2*)(op + 32 * k + 8 * rg) = w;
        }
    ss += __shfl_xor(ss, 32);
    if (hi == 0) ASSQ[(tokb + qrow) * 4 + h] = ss;
    __syncthreads();
}
}


#define XB_TMO      128
#define XB_XCNT(j)  (256  + 64 * (j))
#define XB_XSUB(j)  (1280 + 64 * (j))
#define XB_XGEN(j)  (2304 + 64 * (j))
#define XB_TOP      3328
#define XB_TOPGEN   3392
#define XCD_BAR_WORDS 3456
#define XB_SPIN_CAP (1u << 18)
__device__ __forceinline__ unsigned xb_ld(unsigned* p)              { return __hip_atomic_load(p, __ATOMIC_RELAXED, __HIP_MEMORY_SCOPE_AGENT); }
__device__ __forceinline__ unsigned xb_add(unsigned* p, unsigned v) { return __hip_atomic_fetch_add(p, v, __ATOMIC_RELAXED, __HIP_MEMORY_SCOPE_AGENT); }
__device__ __forceinline__ unsigned xb_xcc_id() { return (unsigned)__builtin_amdgcn_s_getreg((3 << 11) | 20) & 0xFu; }
#define XB_SPIN(cond, bar) do { unsigned _sp = 0; while (cond) { __builtin_amdgcn_s_sleep(1); \
    if ((++_sp & 255u) == 0u) { if (xb_ld(&(bar)[XB_TMO])) break; if (_sp > XB_SPIN_CAP) { atomicAdd(&(bar)[XB_TMO], 1u); break; } } } } while (0)
struct XcdBarrier { unsigned* bar; unsigned x; volatile LAS unsigned* st; };
__device__ __forceinline__ XcdBarrier xcd_barrier_post(unsigned* bar, volatile LAS unsigned* st) {
    XcdBarrier b; b.bar = bar; b.x = xb_xcc_id(); b.st = st;
    if (threadIdx.x == 0) (void)xb_add(&bar[XB_XCNT(b.x)], 1u);
    return b;
}
__device__ __forceinline__ void xcd_barrier_complete(unsigned* bar, unsigned x, unsigned& nloc, unsigned& nx) {
    const unsigned G = gridDim.x * gridDim.y * gridDim.z;
    unsigned sum, cnt, mine, sp = 0u;
    for (;;) {
        sum = 0u; cnt = 0u; mine = 0u;
#pragma unroll
        for (unsigned j = 0; j < 16; ++j) { const unsigned c = xb_ld(&bar[XB_XCNT(j)]); sum += c; cnt += (c > 0u) ? 1u : 0u; mine = (j == x) ? c : mine; }
        if (sum == G) break;
        __builtin_amdgcn_s_sleep(1);
        if ((++sp & 255u) == 0u) { if (xb_ld(&bar[XB_TMO])) break; if (sp > XB_SPIN_CAP) { atomicAdd(&bar[XB_TMO], 1u); break; } }
    }
    nloc = mine > 0u ? mine : 1u; nx = cnt > 0u ? cnt : 1u;
}
__device__ __forceinline__ void xcd_barrier(const XcdBarrier& b) {
    asm volatile("s_waitcnt vmcnt(0)" ::: "memory");
    __syncthreads();
    if (threadIdx.x == 0) {
        unsigned* bar = b.bar;
        __builtin_amdgcn_s_waitcnt(0);
        unsigned nloc = b.st[0], nx = b.st[1];
        if (nloc == 0u) { xcd_barrier_complete(bar, b.x, nloc, nx); b.st[0] = nloc; b.st[1] = nx; }
        const unsigned old = xb_add(&bar[XB_XSUB(b.x)], 1u);
        const unsigned gen = old / nloc;
        if (old + 1u == (gen + 1u) * nloc) {
            __builtin_amdgcn_fence(__ATOMIC_RELEASE, "agent");
            asm volatile("s_waitcnt vmcnt(0)" ::: "memory");
            const unsigned og = xb_add(&bar[XB_TOP], 1u);
            const unsigned tg = og / nx;
            if (og + 1u == (tg + 1u) * nx) xb_add(&bar[XB_TOPGEN], 1u);
            else XB_SPIN(xb_ld(&bar[XB_TOPGEN]) == tg, bar);
            __builtin_amdgcn_fence(__ATOMIC_ACQUIRE, "agent");
            xb_add(&bar[XB_XGEN(b.x)], 1u);
            asm volatile("s_waitcnt vmcnt(0)" ::: "memory");
        } else {
            XB_SPIN(xb_ld(&bar[XB_XGEN(b.x)]) == gen, bar);
            __builtin_amdgcn_fence(__ATOMIC_ACQUIRE, "agent");
            asm volatile("s_waitcnt vmcnt(0)" ::: "memory");
        }
    }
    __syncthreads();
}
struct Args { const void* in[30]; float* out; unsigned char* ws; };

__device__ __forceinline__ void blk_sync_mem() { __threadfence_block(); __syncthreads(); }

template <class SrcCol, class KScale>
__device__ __forceinline__ void transpose_item(const float* __restrict__ W, int K, int N, bf16_t* WT, int nout, LAS float* scr, int item, int lane, SrcCol sc, KScale ks) {
    const int nblk = nout / 32, kb = item / nblk, nb = item % nblk, k0 = 64 * kb, n0 = 32 * nb;
    const int src = sc(n0 + (lane & 31));
#pragma unroll 8
    for (int i = 0; i < 32; ++i) { const int kk = 2 * i + (lane >> 5); scr[kk * 33 + (lane & 31)] = src >= 0 ? W[(size_t)(k0 + kk) * N + src] * ks(k0 + kk) : 0.f; }
    asm volatile("s_waitcnt lgkmcnt(0)" ::: "memory");
    const int c = lane & 7;
#pragma unroll
    for (int j = 0; j < 4; ++j) { const int n = (lane >> 3) + 8 * j; const LAS float* s = scr + (8 * c) * 33 + n;
        u32x4 o; o.x = pk2(s[0 * 33], s[1 * 33]); o.y = pk2(s[2 * 33], s[3 * 33]); o.z = pk2(s[4 * 33], s[5 * 33]); o.w = pk2(s[6 * 33], s[7 * 33]);
        *(u32x4*)(WT + (size_t)(n0 + n) * K + k0 + 8 * c) = o; }
    asm volatile("s_waitcnt lgkmcnt(0)" ::: "memory");
}
__device__ __forceinline__ void cpowd(double lrdt, double lidt, int e, double& re, double& im) { const double mag = exp(lrdt * e), a = lidt * e; re = mag * cos(a); im = mag * sin(a); }

__device__ __forceinline__ const float* ldarg(int i) {
    const __attribute__((address_space(4))) char* kp = (const __attribute__((address_space(4))) char*)__builtin_amdgcn_kernarg_segment_ptr();
    int off = i * 8; asm volatile("" : "+s"(off));
    return *(const float* const __attribute__((address_space(4)))*)(kp + off);
}
#define WT_in ((bf16_t*)(ws + WS_WIN))
#define WT_uq ((bf16_t*)(ws + WS_WUQ))
#define WT_ukv ((bf16_t*)(ws + WS_WUKV))
#define WT_glu ((bf16_t*)(ws + WS_WGLU))
#define WT_out ((bf16_t*)(ws + WS_WOUT))
#define WT_up ((bf16_t*)(ws + WS_WUP))
#define WT_down ((bf16_t*)(ws + WS_WDOWN))
#define WS5S ((bf16_t*)(ws + WS_WS5S))
#define WS5T ((bf16_t*)(ws + WS_WS5T))
#define MOD ((float*)(ws + WS_MOD))
#define A16 ((f32x2*)(ws + WS_MOD + 512 * 1024))
#define CS ((f32x2*)(ws + WS_CS))
#define SSQ1 ((float*)(ws + WS_SSQ1))
#define ASSQ ((float*)(ws + WS_ASSQ))
#define SSQ2 ((float*)(ws + WS_SSQ2))
#define SSQ3 ((float*)(ws + WS_SSQ3))
#define SSQ4 ((float*)(ws + WS_SSQ4))
#define HALO ((float*)(ws + WS_HALO))
#define FIX ((float*)(ws + WS_FIX))
#define YSSM ((bf16_t*)(ws + WS_YSSM))
#define AS ((bf16_t*)(ws + WS_AS))
#define H1 ((bf16_t*)(ws + WS_H1))
#define Z ((bf16_t*)(ws + WS_Z))
#define UX ((bf16_t*)(ws + WS_UX))
#define SB ((float*)(ws + WS_SB))
#define Qb ((bf16_t*)(ws + WS_Q))
#define KN ((bf16_t*)(ws + WS_KN))
#define VT ((bf16_t*)(ws + WS_VT))
#define KR ((bf16_t*)(ws + WS_KR))
#define H2 ((bf16_t*)(ws + WS_H2))
#define RST ((float*)(ws + WS_RST))
#define ACT ((bf16_t*)(ws + WS_ACT))
#define PHASE_IDS int tid_l = threadIdx.x; asm volatile("" : "+v"(tid_l)); const int tid = tid_l, lane = tid & 63, wid = __builtin_amdgcn_readfirstlane(tid >> 6), gw = bx * 8 + wid; (void)gw; (void)lane; (void)tid;
__global__ void __launch_bounds__(512, 2) fwd_kernel(Args a) {
    extern __shared__ __attribute__((aligned(16))) unsigned char lds_raw[];
    LAS unsigned char* lds = (LAS unsigned char*)lds_raw;
    cg::grid_group grid = cg::this_grid();
    const int tid = threadIdx.x, lane = tid & 63, wid = __builtin_amdgcn_readfirstlane(tid >> 6);
    const int G = gridDim.x, bx = blockIdx.x, gw = bx * 8 + wid, NGW = G * 8;
    volatile LAS unsigned* bst = (volatile LAS unsigned*)(lds + 139264);
    if (tid < 4) bst[tid] = 0u;
    __syncthreads();
    const XcdBarrier xbar = xcd_barrier_post((unsigned*)(a.ws + WS_BAR), bst);
    float* const out = a.out; unsigned char* const ws = a.ws;
#if PHM & 1
    { PHASE_IDS
    REP(1) {
        LAS float* cond = (LAS float*)lds;
        LAS float* red = (LAS float*)(lds + 32768);
        const float* cvec = ldarg(1); const float* w_mod = ldarg(3); const float* b_mod = ldarg(4);
        for (int cb = bx; cb < 96; cb += G) {
            for (int i = tid; i < 8192; i += 512) { const float v = cvec[i]; cond[i] = v * sigmoid_f(v); }
            __syncthreads();
            float accb[8];
#pragma unroll
            for (int b = 0; b < 8; ++b) accb[b] = 0.f;
            const int col = cb * 64 + lane;
#pragma unroll 8
            for (int k = wid * 128; k < wid * 128 + 128; ++k) { const float wv = w_mod[(size_t)k * 6144 + col];
#pragma unroll
                for (int b = 0; b < 8; ++b) accb[b] += cond[b * 1024 + k] * wv; }
#pragma unroll
            for (int b = 0; b < 8; ++b) red[(wid * 8 + b) * 64 + lane] = accb[b];
            __syncthreads();
            { float s = b_mod[col];
#pragma unroll
              for (int w = 0; w < 8; ++w) s += red[(w * 8 + wid) * 64 + lane];
              MOD[wid * 6144 + col] = s; }
            __syncthreads();
        }
        __syncthreads();
        LAS float* scr = (LAS float*)(lds + wid * 16384);
        constexpr int I_IN = 16 * 40, I_UQ = 6 * 24, I_UKV = 4 * 32, I_GLU = 8 * 32, I_OUT = 16 * 32, I_UP = 16 * 176, I_DOWN = 44 * 32, I_S5 = 512;
        constexpr int NITEMS = I_IN + I_UQ + I_UKV + I_GLU + I_OUT + I_UP + I_DOWN + I_S5;
        for (int it = gw; it < NITEMS; it += NGW) {
            int r = it;
            if (r < I_S5) {
                const int g = r >> 4, d = r & 15, p = lane;
                const float* lam_re = ldarg(11); const float* lam_im = ldarg(12); const float* log_dt = ldarg(13); const float* b_re = ldarg(14); const float* b_im = ldarg(15); const float* c_re = ldarg(16); const float* c_im = ldarg(17);
                const double lr = (double)fminf(lam_re[g * 64 + p], -1e-4f), li = (double)lam_im[g * 64 + p], dt = exp((double)log_dt[g]);
                const double lrdt = lr * dt, lidt = li * dt;
                double are, aim; cpowd(lrdt, lidt, 1, are, aim);
                const double nr = are - 1.0, ni = aim, den = lr * lr + li * li;
                const double zre = (nr * lr + ni * li) / den, zim = (ni * lr - nr * li) / den;
                double e_re, e_im;
                cpowd(lrdt, lidt, d, e_re, e_im);
                scr[p] = (float)(e_re * zre - e_im * zim); scr[64 + p] = (float)(e_re * zim + e_im * zre);
                asm volatile("s_waitcnt lgkmcnt(0)" ::: "memory");
                bf16_t* Tg = WS5T + (size_t)g * 256 * 384; bf16_t* Sg = WS5S + (size_t)g * 256 * 256;
#pragma unroll 1
                for (int k4 = 0; k4 < 4; ++k4) {
                    const int idx = lane + 64 * k4, h = idx >> 4, hp = idx & 15;
                    float s = 0.f;
                    for (int pp = 0; pp < 64; ++pp) {
                        const float Cr = c_re[(g * 16 + h) * 64 + pp], Ci = c_im[(g * 16 + h) * 64 + pp], Br = b_re[(g * 64 + pp) * 16 + hp], Bi = b_im[(g * 64 + pp) * 16 + hp];
                        const float Wr = scr[pp], Wi = scr[64 + pp];
                        s += (Cr * Wr - Ci * Wi) * Br - (Cr * Wi + Ci * Wr) * Bi;
                    }
                    const bf16_t kv = (bf16_t)(pk2(s, 0.f) & 0xffffu);
                    for (int i = d; i < 16; ++i) Tg[(size_t)(i * 16 + h) * 384 + (i - d) * 16 + hp] = kv;
                    if (d >= 1) for (int i = 0; i + d < 16; ++i) Tg[(size_t)(i * 16 + h) * 384 + (i + d) * 16 + hp] = 0;
                }
                cpowd(lrdt, lidt, d + 1, e_re, e_im);
                for (int h = 0; h < 16; ++h) { const double Cr = c_re[(g * 16 + h) * 64 + p], Ci = c_im[(g * 16 + h) * 64 + p];
                    Tg[(size_t)(d * 16 + h) * 384 + 256 + p] = (bf16_t)(pk2((float)(Cr * e_re - Ci * e_im), 0.f) & 0xffffu);
                    Tg[(size_t)(d * 16 + h) * 384 + 320 + p] = (bf16_t)(pk2((float)(-(Cr * e_im + Ci * e_re)), 0.f) & 0xffffu); }
                cpowd(lrdt, lidt, 15 - d, e_re, e_im);
                { const double fr_ = e_re * zre - e_im * zim, fi_ = e_re * zim + e_im * zre;
                  for (int hp = 0; hp < 16; ++hp) { const double Br = b_re[(g * 64 + p) * 16 + hp], Bi = b_im[(g * 64 + p) * 16 + hp];
                      Sg[(size_t)p * 256 + d * 16 + hp] = (bf16_t)(pk2((float)(fr_ * Br - fi_ * Bi), 0.f) & 0xffffu);
                      Sg[(size_t)(64 + p) * 256 + d * 16 + hp] = (bf16_t)(pk2((float)(fr_ * Bi + fi_ * Br), 0.f) & 0xffffu);
                      Sg[(size_t)(128 + p) * 256 + d * 16 + hp] = 0; Sg[(size_t)(192 + p) * 256 + d * 16 + hp] = 0; } }
                if (d == 0) { cpowd(lrdt, lidt, 16, e_re, e_im); A16[g * 64 + p] = (f32x2){(float)e_re, (float)e_im}; }
                asm volatile("s_waitcnt lgkmcnt(0)" ::: "memory");
                continue;
            }
            r -= I_S5;
            auto one = [](int) { return 1.f; };
            if (r < I_IN) { transpose_item(ldarg(6), 1024, NIN, WT_in, NINP, scr, r, lane,
                [](int n) { return n >= NIN ? -1 : (n >= 640 && n < 704) ? 640 + ((n - 640) >> 1) + 32 * ((n - 640) & 1) : n; }, one); continue; } r -= I_IN;
            if (r < I_UQ) { const float* q_norm_g = ldarg(7); transpose_item(ldarg(8), 384, 768, WT_uq, 768, scr, r, lane,
                [](int n) { const int hh = n / 192, w = n % 192; return w < 128 ? n : hh * 192 + 128 + ((w - 128) >> 1) + 32 * ((w - 128) & 1); }, [=](int k) { return q_norm_g[k]; }); continue; } r -= I_UQ;
            if (r < I_UKV) { const float* kv_norm_g = ldarg(9); transpose_item(ldarg(10), 256, 1024, WT_ukv, 1024, scr, r, lane, [](int n) { return n; }, [=](int k) { return kv_norm_g[k]; }); continue; } r -= I_UKV;
            if (r < I_GLU) { transpose_item(ldarg(19), 512, 1024, WT_glu, 1024, scr, r, lane, [](int n) { return 512 * ((n >> 7) & 1) + 128 * (n >> 8) + (n & 127); }, one); continue; } r -= I_GLU;
            if (r < I_OUT) { const float* attn_out_g = ldarg(21); const float* ssm_out_g = ldarg(22); transpose_item(ldarg(23), 1024, 1024, WT_out, 1024, scr, r, lane, [](int n) { return n; }, [=](int k) { return k < 512 ? attn_out_g[k] : ssm_out_g[k - 512]; }); continue; } r -= I_OUT;
            if (r < I_UP) { transpose_item(ldarg(25), 1024, 2 * DFF, WT_up, 2 * DFF, scr, r, lane, [](int n) { return DFF * ((n >> 7) & 1) + 128 * (n >> 8) + (n & 127); }, one); continue; } r -= I_UP;
            transpose_item(ldarg(28), DFF, 1024, WT_down, 1024, scr, r, lane, [](int n) { return n; }, one);
        }
        {
            LAS double* invf = (LAS double*)lds;
            __syncthreads();
            if (tid < 32) invf[tid] = exp2(-(double)tid * (13.287712379549449 / 32.0)) * 0.15915494309189535;
            __syncthreads();
            const int* pos = (const int*)ldarg(2);
            for (size_t i = (size_t)bx * 512 + tid; i < (size_t)NT * 32; i += (size_t)G * 512) {
                const int t = (int)(i >> 5), f = (int)(i & 31);
                double rv = (double)pos[t] * invf[f]; rv -= rint(rv);
                const float fr = (float)rv;
                CS[i] = (f32x2){__builtin_amdgcn_cosf(fr), __builtin_amdgcn_sinf(fr)};
            }
        }
        __syncthreads();
    }
    grid.sync();

    }
#endif
#if PHM & 2
    { PHASE_IDS
    REP(2) { const float* x = ldarg(0); const float* ln1_g = ldarg(5);
    for (int ch = gw; ch < NT / 32; ch += NGW) {
        const int b = (ch * 32) >> 13;
        f32x4 cs[4], sh[4];
#pragma unroll
        for (int j = 0; j < 4; ++j) { const int c0 = 4 * lane + 256 * j; const f32x4 gg = *(const f32x4*)(ln1_g + c0), sc = *(const f32x4*)(MOD + b * 6144 + 1024 + c0);
            cs[j] = gg * (sc + 1.f); sh[j] = *(const f32x4*)(MOD + b * 6144 + c0); }
        for (int rr = 0; rr < 32; ++rr) {
            const size_t row = (size_t)ch * 32 + rr;
            const f32x4* xr = (const f32x4*)(x + row * 1024) + lane;
            f32x4 v[4]; float s = 0.f;
#pragma unroll
            for (int j = 0; j < 4; ++j) { v[j] = xr[64 * j]; s += dot4(v[j]); }
            const float rstd = __builtin_amdgcn_rsqf(wave_sum(s) * (1.f / 1024.f) + EPS);
            u32x2* o8 = (u32x2*)(H1 + row * 1024) + lane;
#pragma unroll
            for (int j = 0; j < 4; ++j) { const f32x4 y = v[j] * rstd * cs[j] + sh[j]; u32x2 w; w.x = pk2(y[0], y[1]); w.y = pk2(y[2], y[3]); o8[64 * j] = w; }
        }
    }
    }
    xcd_barrier(xbar);

    }
#endif
#if PHM & 4
    { PHASE_IDS
    REP(4) {
        pg8::Gemm g{H1, WT_in, 1024, 1024}; pg8::StaticOrder S; S.init(256, 5, G, bx, (size_t)256 * 1024 * 2, (size_t)256 * 1024 * 2);
        Epi1 E{Z, KR, UX, SSQ1, CS};
        pg8::gemm_phase(lds, g, S, E);
    }
    xcd_barrier(xbar);

    }
#endif
#if PHM & 8
    { PHASE_IDS
    REP(8) {
#if P3SEL & 1
        { pg8::Gemm g{Z, WT_uq, 384, 640}; pg8::StaticOrder S; S.init(256, 3, G, bx, (size_t)256 * 640 * 2, (size_t)256 * 384 * 2); EpiQ E{Qb, SSQ1, CS}; pg8::gemm_phase(lds, g, S, E); }
#endif
#if P3SEL & 2
        { pg8::Gemm g{Z + 384, WT_ukv, 256, 640}; pg8::StaticOrder S; S.init(256, 4, G, bx, (size_t)256 * 640 * 2, (size_t)256 * 256 * 2); EpiKV E{KN, VT, SSQ1}; pg8::gemm_phase(lds, g, S, E); }
#endif
#if P3SEL & 4
        for (int bg = bx; bg < 256; bg += G) { pg8::Gemm g{UX, WS5S, 256, 384}; pg8::BGOrder S{bg & 7, bg >> 3, (size_t)4096 * 384 * 2, (size_t)256 * 256 * 2, (size_t)256 * 384 * 2}; EpiS5a E{SB}; pg8::gemm_phase(lds, g, S, E); }
#endif
    }
    xcd_barrier(xbar);

    }
#endif
#if PHM & 16
    { PHASE_IDS
#if P4SEL & 1
    REP(16) for (int bg = bx; bg < 256; bg += G) {
        const int b = bg & 7, g = bg >> 3;
        {
            const int p = lane; const f32x2 A = A16[g * 64 + p];
            const float* sb = SB + ((size_t)g * 4096 + b * 512 + 64 * wid) * 128; bf16_t* ux = UX + ((size_t)g * 4096 + b * 512 + 64 * wid) * 384 + 256;
            LAS float* ex = (LAS float*)lds;
            float xr = 0.f, xi = 0.f;
            for (int c0 = 0; c0 < 64; c0 += 8) {
                float sr[8], si[8];
#pragma unroll
                for (int k = 0; k < 8; ++k) { sr[k] = sb[(size_t)(c0 + k) * 128 + p]; si[k] = sb[(size_t)(c0 + k) * 128 + 64 + p]; }
#pragma unroll
                for (int k = 0; k < 8; ++k) { const float nr = A.x * xr - A.y * xi + sr[k], ni = A.x * xi + A.y * xr + si[k]; xr = nr; xi = ni; }
            }
            ex[wid * 128 + p] = xr; ex[wid * 128 + 64 + p] = xi;
            __syncthreads();
            float ar = A.x, ai = A.y;
#pragma unroll
            for (int k = 0; k < 6; ++k) { const float nr = ar * ar - ai * ai, ni = 2.f * ar * ai; ar = nr; ai = ni; }
            xr = 0.f; xi = 0.f;
            for (int v = 0; v < wid; ++v) { const float er = ex[v * 128 + p], ei = ex[v * 128 + 64 + p]; const float nr = ar * xr - ai * xi + er, ni = ar * xi + ai * xr + ei; xr = nr; xi = ni; }
            for (int c0 = 0; c0 < 64; c0 += 8) {
                float sr[8], si[8];
#pragma unroll
                for (int k = 0; k < 8; ++k) { sr[k] = sb[(size_t)(c0 + k) * 128 + p]; si[k] = sb[(size_t)(c0 + k) * 128 + 64 + p]; }
#pragma unroll
                for (int k = 0; k < 8; ++k) {
                    ux[(size_t)(c0 + k) * 384 + p] = (bf16_t)(pk2(xr, 0.f) & 0xffffu); ux[(size_t)(c0 + k) * 384 + 64 + p] = (bf16_t)(pk2(xi, 0.f) & 0xffffu);
                    const float nr = A.x * xr - A.y * xi + sr[k], ni = A.x * xi + A.y * xr + si[k]; xr = nr; xi = ni;
                }
            }
        }
        blk_sync_mem();
        pg8::Gemm gm{UX, WS5T, 384, 384}; pg8::BGOrder S{b, g, (size_t)4096 * 384 * 2, (size_t)256 * 384 * 2, (size_t)256 * 384 * 2}; EpiS5c E{YSSM, UX, ldarg(18)};
        pg8::gemm_phase(lds, gm, S, E);
    }
#endif
    __syncthreads();
#if P4SEL & 2
    REP(32) for (int v = bx; v < 256; v += G) {
        const int vv = (v & 7) * 32 + (v >> 3);
        const int bh = vv >> 3, s = vv & 7;
#pragma unroll 1
        for (int i = 0; i < 4; ++i) { const int qb = (i == 0) ? s : (i == 1) ? 15 - s : (i == 2) ? 16 + s : 31 - s;
            att::attn_unit(bh >> 2, bh & 3, qb, Qb, KN, KR, VT, AS, ASSQ, lds); }
    }
#endif
    xcd_barrier(xbar);

    }
#endif
#if PHM & 32
    { PHASE_IDS
    REP(128) { pg8::Gemm g{YSSM, WT_glu, 512, 512}; pg8::StaticOrder S; S.init(256, 4, G, bx, (size_t)256 * 512 * 2, (size_t)256 * 512 * 2); EpiGLU E{AS, SSQ2, ldarg(20)}; pg8::gemm_phase(lds, g, S, E); }
    xcd_barrier(xbar);
    for (int row = bx * 512 + tid; row < NT; row += G * 512) {
        const f32x4 sa = *(const f32x4*)(ASSQ + (size_t)row * 4); const f32x4* sp = (const f32x4*)(SSQ2 + (size_t)row * 16);
        const float rsa = __builtin_amdgcn_rsqf(sum4(sa) * (1.f / 512.f) + EPS), rss = __builtin_amdgcn_rsqf((sum4(sp[0]) + sum4(sp[1]) + sum4(sp[2]) + sum4(sp[3])) * (1.f / 512.f) + EPS);
        RST[(size_t)row * 4] = rsa / rss; RST[(size_t)row * 4 + 1] = rss;
    }
    xcd_barrier(xbar);
    REP(128) { pg8::Gemm g{AS, WT_out, 1024, 1024}; pg8::StaticOrder S; S.init(256, 4, G, bx, (size_t)256 * 1024 * 2, (size_t)256 * 1024 * 2); EpiOut E{ldarg(0), out, MOD + 2048, SSQ3, RST}; pg8::gemm_phase(lds, g, S, E); }
    xcd_barrier(xbar);
    REP(512) for (int ch = gw; ch < NT / 32; ch += NGW) {
        const int b = (ch * 32) >> 13;
        f32x4 cs[4], sh[4];
#pragma unroll
        for (int j = 0; j < 4; ++j) { const int c0 = 4 * lane + 256 * j; const f32x4 gg = *(const f32x4*)(ldarg(24) + c0), sc = *(const f32x4*)(MOD + b * 6144 + 4096 + c0);
            cs[j] = gg * (sc + 1.f); sh[j] = *(const f32x4*)(MOD + b * 6144 + 3072 + c0); }
        for (int rr = 0; rr < 32; ++rr) {
            const size_t row = (size_t)ch * 32 + rr;
            const float rstd = __builtin_amdgcn_rsqf(wave_sum(SSQ3[row * 32 + (lane & 31)]) * (0.5f / 1024.f) + EPS);
            const f32x4* xr = (const f32x4*)(out + row * 1024) + lane; u32x2* o8 = (u32x2*)(H2 + row * 1024) + lane;
#pragma unroll
            for (int j = 0; j < 4; ++j) { const f32x4 y = xr[64 * j] * rstd * cs[j] + sh[j]; u32x2 w; w.x = pk2(y[0], y[1]); w.y = pk2(y[2], y[3]); o8[64 * j] = w; }
        }
    }
    xcd_barrier(xbar);

    }
#endif
#if PHM & 64
    { PHASE_IDS
    REP(64) {
        pg8::Gemm g{H2, WT_up, 1024, 1024}; pg8::StaticOrder S; S.init(256, 22, G, bx, (size_t)256 * 1024 * 2, (size_t)256 * 1024 * 2);
        EpiUp E{ACT, HALO, FIX, ldarg(26), ldarg(27)};
        pg8::gemm_phase(lds, g, S, E);
    }
    xcd_barrier(xbar);

    }
#endif
#if PHM & 128
    { PHASE_IDS
    for (int pm = bx; pm < 256; pm += G) {
        const float* conv_w = ldarg(26); const float* conv_b = ldarg(27);
        for (int it = tid; it < 4 * DFF; it += 512) {
            const int col = it % DFF, sj = it / DFF, wr = sj >> 1, jj = sj & 1;
            const float* f = FIX + ((size_t)(pm * 2 + wr) * 4) * DFF + col;
            const float g0 = f[0], v0 = f[DFF], g1 = f[2 * DFF], v1 = f[3 * DFF];
            float h6 = 0.f, h7 = 0.f;
            if (wr == 1) { const float* hp = HALO + ((size_t)(pm * 2) * 2) * DFF + col; h6 = hp[0]; h7 = hp[DFF]; }
            else if ((pm & 31) != 0) { const float* hp = HALO + ((size_t)((pm - 1) * 2 + 1) * 2) * DFF + col; h6 = hp[0]; h7 = hp[DFF]; }
            const float w0 = conv_w[col], w1 = conv_w[DFF + col], w2 = conv_w[2 * DFF + col], bb = conv_b[col];
            const float y = jj == 0 ? gelu_t(bb + w0 * h6 + w1 * h7 + w2 * g0) * v0 : gelu_t(bb + w0 * h7 + w1 * g0 + w2 * g1) * v1;
            ACT[((size_t)pm * 256 + 128 * wr + jj) * DFF + col] = (bf16_t)(pk2(y, 0.f) & 0xffffu);
        }
    }
    xcd_barrier(xbar);
    { pg8::Gemm g{ACT, WT_down, DFF, DFF}; pg8::StaticOrder S; S.init(256, 4, G, bx, (size_t)256 * DFF * 2, (size_t)256 * DFF * 2);
      EpiDownNorm E{out, out, MOD + 5120, ldarg(29), (unsigned*)ASSQ, (unsigned*)(ws + WS_BAR) + 4096, lds + 131072}; pg8::gemm_phase(lds, g, S, E); }
    }
#endif
}

extern "C" void kernel_launch(void* const* d_in, const int* in_sizes, int n_in, void* d_out, int out_size, void* d_ws, size_t ws_size, hipStream_t stream) {
    constexpr int LDSB = 147456;
    static int grid = 0;
    if (!grid) {
        if (n_in != 30 || out_size != NT * DM || ws_size < WS_END) { fprintf(stderr, "kernel_launch: unexpected problem (n_in %d out %d ws %zu need %zu)\n", n_in, out_size, ws_size, (size_t)WS_END); grid = -1; return; }
        int dev = 0, cus = 0, per = 0;
        (void)hipGetDevice(&dev);
        (void)hipDeviceGetAttribute(&cus, hipDeviceAttributeMultiprocessorCount, dev);
        (void)hipFuncSetAttribute((const void*)fwd_kernel, hipFuncAttributeMaxDynamicSharedMemorySize, LDSB);
        (void)hipOccupancyMaxActiveBlocksPerMultiprocessor(&per, (const void*)fwd_kernel, 512, LDSB);
        if (per < 1) per = 1;
        grid = cus * per; if (grid > 256) grid = 256;
    }
    if (grid < 0) return;
    (void)hipMemsetAsync((char*)d_ws + WS_BAR, 0, (4096 + 64 * 256) * 4, stream);
    Args a{};
    for (int i = 0; i < 30; ++i) a.in[i] = d_in[i];
    a.out = (float*)d_out; a.ws = (unsigned char*)d_ws;
    void* args[] = {&a};
    hipError_t e = hipLaunchCooperativeKernel((const void*)fwd_kernel, dim3(grid), dim3(512), args, LDSB, stream);
    if (e != hipSuccess) fprintf(stderr, "cooperative launch failed: %s (grid %d)\n", hipGetErrorString(e), grid);
}
```

```cpp
#include <hip/hip_runtime.h>
#include <hip/hip_cooperative_groups.h>
#include <cstdio>
#include <cstdint>
namespace cg = cooperative_groups;
#ifndef PHM
#define PHM 255
#endif
#ifndef ATT_SGB
#define ATT_SGB 0
#endif
#ifndef DBL
#define DBL 0
#endif
#define REP(bit) for (int rep_ = 0; rep_ < ((DBL & (bit)) ? 2 : 1); ++rep_)
#ifndef P3SEL
#define P3SEL 7
#endif
#ifndef P4SEL
#define P4SEL 3
#endif

#define LAS __attribute__((address_space(3)))
typedef unsigned short bf16_t;
typedef short bf16x8 __attribute__((ext_vector_type(8)));
typedef float f32x2 __attribute__((ext_vector_type(2)));
typedef float f32x4 __attribute__((ext_vector_type(4)));
typedef float f32x16 __attribute__((ext_vector_type(16)));
typedef unsigned u32x2 __attribute__((ext_vector_type(2)));
typedef unsigned u32x4 __attribute__((ext_vector_type(4)));
typedef __bf16 bf16x2_t __attribute__((ext_vector_type(2)));

constexpr int NB = 8, SEQ = 8192, DM = 1024, NT = NB * SEQ;
constexpr int NIN = 1216, NINP = 1280;
constexpr int DFF = 2816;
constexpr float EPS = 1e-6f;
constexpr float QSCALE = 0.07216878364870322f * 1.4426950408889634f;

constexpr size_t MiB = 1u << 20;
constexpr size_t WS_WIN = 0 * MiB;
constexpr size_t WS_WUQ = 3 * MiB;
constexpr size_t WS_WUKV = 4 * MiB;
constexpr size_t WS_WGLU = 5 * MiB;
constexpr size_t WS_WOUT = 6 * MiB;
constexpr size_t WS_WUP = 8 * MiB;
constexpr size_t WS_WDOWN = 19 * MiB;
constexpr size_t WS_WS5S = 25 * MiB;
constexpr size_t WS_WS5T = 29 * MiB;
constexpr size_t WS_MOD = 35 * MiB;
constexpr size_t WS_BAR = 35 * MiB + 768 * 1024;
constexpr size_t WS_CS = 36 * MiB;
constexpr size_t WS_SSQ1 = 52 * MiB;
constexpr size_t WS_ASSQ = 60 * MiB;
constexpr size_t WS_SSQ2 = 61 * MiB;
constexpr size_t WS_SSQ3 = 65 * MiB;
constexpr size_t WS_SSQ4 = 73 * MiB;
constexpr size_t WS_HALO = 81 * MiB;
constexpr size_t WS_FIX = 92 * MiB;
constexpr size_t WS_YSSM = 114 * MiB;
constexpr size_t WS_AS = 178 * MiB;
constexpr size_t WS_R1 = 306 * MiB;
constexpr size_t WS_H1 = WS_R1;
constexpr size_t WS_Z = WS_R1 + 128 * MiB;
constexpr size_t WS_UX = WS_R1 + 208 * MiB;
constexpr size_t WS_SB = WS_R1 + 304 * MiB;
constexpr size_t WS_Q = WS_R1 + 368 * MiB;
constexpr size_t WS_KN = WS_R1 + 464 * MiB;
constexpr size_t WS_VT = WS_R1 + 528 * MiB;
constexpr size_t WS_KR = WS_R1 + 592 * MiB;
constexpr size_t WS_RST = WS_R1 + 592 * MiB;
constexpr size_t WS_H2 = WS_R1;
constexpr size_t WS_ACT = WS_R1 + 128 * MiB;
constexpr size_t WS_END = WS_R1 + 600 * MiB;

__device__ __forceinline__ unsigned pk2(float lo, float hi) { f32x2 v = {lo, hi}; bf16x2_t b = __builtin_convertvector(v, bf16x2_t); return __builtin_bit_cast(unsigned, b); }
__device__ __forceinline__ u32x4 pack8(f32x4 a, f32x4 b) { u32x4 w; w.x = pk2(a[0], a[1]); w.y = pk2(a[2], a[3]); w.z = pk2(b[0], b[1]); w.w = pk2(b[2], b[3]); return w; }
__device__ __forceinline__ float bflo(unsigned w) { return __uint_as_float(w << 16); }
__device__ __forceinline__ float bfhi(unsigned w) { return __uint_as_float(w & 0xffff0000u); }
__device__ __forceinline__ float sum4(f32x4 v) { return (v[0] + v[1]) + (v[2] + v[3]); }
__device__ __forceinline__ float dot4(f32x4 v) { return (v[0] * v[0] + v[1] * v[1]) + (v[2] * v[2] + v[3] * v[3]); }
__device__ __forceinline__ float red_fq(float v) { v += __shfl_xor(v, 16); v += __shfl_xor(v, 32); return v; }
__device__ __forceinline__ float wave_sum(float v) {
#pragma unroll
    for (int o = 1; o < 64; o <<= 1) v += __shfl_xor(v, o);
    return v;
}
__device__ __forceinline__ float gelu_t(float x) {
    const float u = 0.7978845608028654f * (x + 0.044715f * x * x * x);
    const float e = __builtin_amdgcn_exp2f(-2.885390081777927f * u);
    return x * __builtin_amdgcn_rcpf(1.f + e);
}
__device__ __forceinline__ float sigmoid_f(float g) { return __builtin_amdgcn_rcpf(1.f + __builtin_amdgcn_exp2f(-1.4426950408889634f * g)); }
__device__ __forceinline__ void sincos_d(double ang, float& s, float& c) {
    double rv = ang * 0.15915494309189535; rv -= rint(rv); const float r = (float)(rv * 6.283185307179586);
    s = sinf(r); c = cosf(r);
}

namespace pg8 {
constexpr int BM = 256, BK = 64, HALF = 128, HTB = HALF * BK * 2, STAGE_BYTES = 8 * HTB, NXCD = 8, WGM = 4;
__host__ __device__ __forceinline__ int lds_byte(int r, int c) { const int st = (r >> 4) * 2 + (c >> 5), rr = r & 15, cc = c & 31, ob = rr * 64 + cc * 2; return st * 1024 + (ob ^ (((ob >> 9) & 1) << 5)); }
__host__ __device__ __forceinline__ void stage_rc(int b, int& R, int& C) { const int st = b / 1024, sb = b % 1024, swz = sb ^ (((sb >> 9) & 1) << 5); R = (st >> 1) * 16 + swz / 64; C = (st & 1) * 32 + (swz % 64) / 2; }
__host__ __device__ __forceinline__ int perm32(int rho) { const int n = rho >> 4, i = rho & 15; return 8 * (i >> 2) + 4 * n + (i & 3); }

struct Unit { int pm, pn, g; size_t aoff, boff; };
struct Gemm { const bf16_t* A; const bf16_t* Bt; int K; int lda; };

struct StaticOrder {
    int nM, nN, nwg, G, c; size_t tA, tB;
    __device__ void init(int nM_, int nN_, int G_, int c_, size_t tA_, size_t tB_) { nM = nM_; nN = nN_; nwg = nM * nN; G = G_; c = c_; tA = tA_; tB = tB_; }
    __device__ bool next(int i, Unit& u) const {
        const long L = (long)i * G + c; if (L >= nwg) return false;
        int wgid = (int)L; { const int q = nwg / NXCD, r = nwg % NXCD, xcd = wgid % NXCD, off = wgid / NXCD; wgid = (xcd < r ? xcd * (q + 1) : r * (q + 1) + (xcd - r) * q) + off; }
        const int nig = WGM * nN, gid = wgid / nig, fm = gid * WGM, gsz = (nM - fm) < WGM ? (nM - fm) : WGM;
        u.pm = fm + ((wgid % nig) % gsz); u.pn = (wgid % nig) / gsz; u.g = 0; u.aoff = (size_t)u.pm * tA; u.boff = (size_t)u.pn * tB; return true;
    }
};
struct GroupOrder {
    int G, c; size_t gA, gB, tA;
    __device__ bool next(int i, Unit& u) const { const long L = (long)i * G + c; if (L >= 512) return false; u.g = (int)(L >> 4); u.pm = (int)(L & 15); u.pn = 0; u.aoff = (size_t)u.g * gA + (size_t)u.pm * tA; u.boff = (size_t)u.g * gB; return true; }
};
struct PanelOrder {
    int pm, nN; size_t tA, tB;
    __device__ bool next(int i, Unit& u) const { if (i >= nN) return false; u.pm = pm; u.pn = i; u.g = 0; u.aoff = (size_t)pm * tA; u.boff = (size_t)i * tB; return true; }
};
struct BGOrder {
    int b, g; size_t gA, gB, tA;
    __device__ bool next(int i, Unit& u) const { if (i >= 2) return false; u.g = g; u.pm = 2 * b + i; u.pn = 0; u.aoff = (size_t)g * gA + (size_t)u.pm * tA; u.boff = (size_t)g * gB; return true; }
};

template <class Epi, class Sched>
__device__ __forceinline__ void gemm_phase(LAS unsigned char* lds, const Gemm g, const Sched& S, const Epi& E) {
    int tid_ = threadIdx.x; asm volatile("" : "+v"(tid_));
    const int tid = tid_, wid = __builtin_amdgcn_readfirstlane(tid >> 6), lane = tid & 63, wr = wid >> 2, wc = wid & 3, fr = lane & 15, fq = lane >> 4;
    int K_ = g.K; asm volatile("" : "+s"(K_));
    const int K = K_, nt = K / BK, lda = g.lda;
    unsigned voffA[2], voffB[2];
#pragma unroll
    for (int i = 0; i < 2; ++i) { int R, C; stage_rc(tid * 16 + i * 8192, R, C); const int Rb = Epi::PERM ? ((R & ~31) + perm32(R & 31)) : R;
        const int Ra = Epi::ROWPERM ? (8 * (16 * (R >> 6) + (R & 15)) + ((R >> 4) & 3)) : R;
        voffA[i] = (unsigned)(Ra * lda + C) * 2u; voffB[i] = (unsigned)(Rb * K + C) * 2u; }
    const size_t kstep = (size_t)(BK * 2);
    const size_t hstepA = (size_t)(Epi::ROWPERM ? 4 : HALF) * lda * 2;
    const size_t hstepB = (size_t)HALF * K * 2;
    const unsigned ldsw = (unsigned)wid * 1024u;
    const int aoff = lds_byte(wr * 64 + fr, fq * 8), boff = lds_byte(wc * 32 + fr, fq * 8);
#define PG8_SA(b, h) (((b) * 2 + (h)) * HTB)
#define PG8_SB(b, h) ((4 + (b) * 2 + (h)) * HTB)
#define PG8_STAGE(bufoff, gbase, voff) do { _Pragma("unroll") for (int _i = 0; _i < 2; ++_i) \
        __builtin_amdgcn_global_load_lds((const unsigned*)((const char*)(gbase) + (voff)[_i]), (LAS unsigned*)(lds + (bufoff) + ldsw + _i * 8192), 16, 0, 0); } while (0)
#define PG8_LDA(dst, b, h) do { _Pragma("unroll") for (int m = 0; m < 4; ++m) _Pragma("unroll") for (int k = 0; k < 2; ++k) dst[m][k] = *(const LAS bf16x8*)(lds + PG8_SA(b, h) + aoff + m * 2048 + k * 1024); } while (0)
#define PG8_LDB(dst, b, h) do { _Pragma("unroll") for (int n = 0; n < 2; ++n) _Pragma("unroll") for (int k = 0; k < 2; ++k) dst[n][k] = *(const LAS bf16x8*)(lds + PG8_SB(b, h) + boff + n * 2048 + k * 1024); } while (0)
#define PG8_MMA(ai, bj, At, Bt) do { __builtin_amdgcn_s_setprio(1); _Pragma("unroll") for (int m = 0; m < 4; ++m) _Pragma("unroll") for (int n = 0; n < 2; ++n) _Pragma("unroll") for (int k = 0; k < 2; ++k) \
        acc[ai][bj][m][n] = __builtin_amdgcn_mfma_f32_16x16x32_bf16(Bt[n][k], At[m][k], acc[ai][bj][m][n], 0, 0, 0); __builtin_amdgcn_s_setprio(0); } while (0)
#define PG8_WAIT_V(n) asm volatile("s_waitcnt vmcnt(" #n ")" ::: "memory")
#define PG8_WAIT_L(n) asm volatile("s_waitcnt lgkmcnt(" #n ")" ::: "memory")
#define PG8_BAR __builtin_amdgcn_s_barrier()
#define PG8_SCHED __builtin_amdgcn_sched_barrier(0)
    Unit cur, nxt; int ui = 0;
    if (!S.next(0, cur)) return;
    f32x4 acc[2][2][4][2];
#pragma unroll
    for (int a = 0; a < 2; ++a)
#pragma unroll
        for (int b = 0; b < 2; ++b)
#pragma unroll
            for (int m = 0; m < 4; ++m)
#pragma unroll
                for (int n = 0; n < 2; ++n) acc[a][b][m][n] = (f32x4){0.f, 0.f, 0.f, 0.f};
    bf16x8 At[4][2], B0[2][2], B1[2][2];
    const char* cA = (const char*)g.A + cur.aoff; const char* cB = (const char*)g.Bt + cur.boff;
    PG8_STAGE(PG8_SB(0, 0), cB, voffB); PG8_STAGE(PG8_SB(0, 1), cB + hstepB, voffB); PG8_STAGE(PG8_SA(0, 0), cA, voffA); PG8_STAGE(PG8_SA(0, 1), cA + hstepA, voffA);
    if (wr == 1) PG8_BAR;
    PG8_WAIT_V(2); PG8_BAR;
    PG8_STAGE(PG8_SB(1, 0), cB + kstep, voffB); PG8_STAGE(PG8_SA(1, 0), cA + kstep, voffA); PG8_STAGE(PG8_SB(1, 1), cB + hstepB + kstep, voffB);
    PG8_WAIT_V(6); PG8_BAR;
    for (;;) {
        const bool has_next = S.next(ui + 1, nxt);
        const char* nA = has_next ? (const char*)g.A + nxt.aoff : cA; const char* nB = has_next ? (const char*)g.Bt + nxt.boff : cB;
#pragma unroll 1
        for (int t = 0; t < nt; t += 2) {
            const bool last = (t == nt - 2);
            const char* a1 = cA + (size_t)(t + 1) * kstep;
            const char* a2 = last ? nA : cA + (size_t)(t + 2) * kstep; const char* b2 = last ? nB : cB + (size_t)(t + 2) * kstep;
            const char* a3 = a2 + kstep; const char* b3 = b2 + kstep;
            if constexpr (Epi::MIDK) { if (t == 8) E.mid(acc, cur, wr, wc, fr, fq); }
            PG8_LDB(B0, 0, 0); PG8_LDB(B1, 0, 1); PG8_SCHED; PG8_LDA(At, 0, 0); PG8_STAGE(PG8_SA(1, 1), a1 + hstepA, voffA);
            PG8_WAIT_V(8); PG8_WAIT_L(0); PG8_BAR; PG8_MMA(0, 0, At, B0); PG8_MMA(0, 1, At, B1); PG8_BAR; PG8_SCHED;
            PG8_LDA(At, 0, 1); PG8_STAGE(PG8_SB(0, 0), b2, voffB); PG8_STAGE(PG8_SB(0, 1), b2 + hstepB, voffB); PG8_STAGE(PG8_SA(0, 0), a2, voffA);
            PG8_WAIT_V(8); PG8_WAIT_L(0); PG8_BAR; PG8_MMA(1, 0, At, B0); PG8_MMA(1, 1, At, B1); PG8_BAR; PG8_SCHED;
            PG8_LDB(B0, 1, 0); PG8_LDB(B1, 1, 1); PG8_SCHED; PG8_LDA(At, 1, 0); PG8_STAGE(PG8_SA(0, 1), a2 + hstepA, voffA);
            PG8_WAIT_V(8); PG8_WAIT_L(0); PG8_BAR; PG8_MMA(0, 0, At, B0); PG8_MMA(0, 1, At, B1); PG8_BAR; PG8_SCHED;
            PG8_LDA(At, 1, 1); PG8_STAGE(PG8_SB(1, 0), b3, voffB); PG8_STAGE(PG8_SB(1, 1), b3 + hstepB, voffB); PG8_STAGE(PG8_SA(1, 0), a3, voffA);
            PG8_WAIT_V(8); PG8_WAIT_L(0); PG8_BAR; PG8_MMA(1, 0, At, B0); PG8_MMA(1, 1, At, B1); PG8_BAR; PG8_SCHED;
        }
        if (wr == 0) PG8_BAR;
        E(acc, cur, wr, wc, fr, fq);
        if (!has_next) break;
#pragma unroll
        for (int a = 0; a < 2; ++a)
#pragma unroll
            for (int b = 0; b < 2; ++b)
#pragma unroll
                for (int m = 0; m < 4; ++m)
#pragma unroll
                    for (int n = 0; n < 2; ++n) acc[a][b][m][n] = (f32x4){0.f, 0.f, 0.f, 0.f};
        cur = nxt; cA = nA; cB = nB; ++ui;
        if (wr == 1) PG8_BAR;
    }
    PG8_WAIT_V(0);
    PG8_BAR;
#undef PG8_SA
#undef PG8_SB
#undef PG8_STAGE
#undef PG8_LDA
#undef PG8_LDB
#undef PG8_MMA
#undef PG8_WAIT_V
#undef PG8_WAIT_L
#undef PG8_BAR
#undef PG8_SCHED
}
}
using pg8::Unit;
typedef f32x4 Acc[2][2][4][2];

struct Epi1 {
    static constexpr bool PERM = true, ROWPERM = false, MIDK = false;
    bf16_t* Z; bf16_t* KR; bf16_t* UX; float* SSQ; const f32x2* CS;
    __device__ __forceinline__ void operator()(const Acc& acc, const Unit& u, int wr, int wc, int fr, int fq) const {
        int rb = u.pm * 256 + wr * 64 + fr;
#pragma unroll
        for (int bj = 0; bj < 2; ++bj) {
            const int gc = u.pn * 256 + bj * 128 + wc * 32, c0 = gc + 8 * fq;
            if (gc >= NIN) continue;
#pragma unroll
            for (int ai = 0; ai < 2; ++ai)
#pragma unroll
                for (int m = 0; m < 4; ++m) {
                    asm volatile("" : "+v"(rb)); const int row = rb + ai * 128 + m * 16;
                    const f32x4 v0 = acc[ai][bj][m][0], v1 = acc[ai][bj][m][1];
                    if (gc < 640) {
                        *(u32x4*)(Z + (size_t)row * 640 + c0) = pack8(v0, v1);
                        const float ss = red_fq(dot4(v0) + dot4(v1));
                        if (fq == 0) SSQ[(size_t)row * 32 + (gc >> 5)] = ss;
                    } else if (gc < 704) {
                        const f32x2* cs = CS + (size_t)row * 32 + ((c0 - 640) >> 1);
                        const f32x2 t0 = cs[0], t1 = cs[1], t2 = cs[2], t3 = cs[3];
                        f32x4 o0, o1;
                        o0[0] = v0[0] * t0.x - v0[1] * t0.y; o0[1] = v0[0] * t0.y + v0[1] * t0.x;
                        o0[2] = v0[2] * t1.x - v0[3] * t1.y; o0[3] = v0[2] * t1.y + v0[3] * t1.x;
                        o1[0] = v1[0] * t2.x - v1[1] * t2.y; o1[1] = v1[0] * t2.y + v1[1] * t2.x;
                        o1[2] = v1[2] * t3.x - v1[3] * t3.y; o1[3] = v1[2] * t3.y + v1[3] * t3.x;
                        *(u32x4*)(KR + (size_t)row * 64 + (c0 - 640)) = pack8(o0, o1);
                    } else {
                        const int ch = c0 - 704, g = ch >> 4, h0 = ch & 15, b = row >> 13, t = row & 8191;
                        *(u32x4*)(UX + ((size_t)g * 4096 + b * 512 + (t >> 4)) * 384 + (t & 15) * 16 + h0) = pack8(v0, v1);
                    }
                    asm volatile("" ::: "memory");
                }
        }
    }
};
struct EpiQ {
    static constexpr bool PERM = true, ROWPERM = false, MIDK = false;
    bf16_t* Q; const float* SSQ; const f32x2* CS;
    __device__ __forceinline__ void operator()(const Acc& acc, const Unit& u, int wr, int wc, int fr, int fq) const {
        int rb = u.pm * 256 + wr * 64 + fr;
#pragma unroll
        for (int ai = 0; ai < 2; ++ai)
#pragma unroll
            for (int m = 0; m < 4; ++m) {
                asm volatile("" : "+v"(rb)); const int row = rb + ai * 128 + m * 16;
                const f32x4* sp = (const f32x4*)(SSQ + (size_t)row * 32);
                const float rs = __builtin_amdgcn_rsqf((sum4(sp[0]) + sum4(sp[1]) + sum4(sp[2])) * (1.f / 384.f) + EPS) * QSCALE;
#pragma unroll
                for (int bj = 0; bj < 2; ++bj) {
                    const int gc = u.pn * 256 + bj * 128 + wc * 32, c0 = gc + 8 * fq, w = gc % 192;
                    f32x4 v0 = acc[ai][bj][m][0] * rs, v1 = acc[ai][bj][m][1] * rs;
                    if (w >= 128) {
                        const f32x2* cs = CS + (size_t)row * 32 + ((w - 128 + 8 * fq) >> 1);
                        const f32x2 t0 = cs[0], t1 = cs[1], t2 = cs[2], t3 = cs[3];
                        f32x4 o0, o1;
                        o0[0] = v0[0] * t0.x - v0[1] * t0.y; o0[1] = v0[0] * t0.y + v0[1] * t0.x;
                        o0[2] = v0[2] * t1.x - v0[3] * t1.y; o0[3] = v0[2] * t1.y + v0[3] * t1.x;
                        o1[0] = v1[0] * t2.x - v1[1] * t2.y; o1[1] = v1[0] * t2.y + v1[1] * t2.x;
                        o1[2] = v1[2] * t3.x - v1[3] * t3.y; o1[3] = v1[2] * t3.y + v1[3] * t3.x;
                        v0 = o0; v1 = o1;
                    }
                    *(u32x4*)(Q + (size_t)row * 768 + c0) = pack8(v0, v1);
                }
                asm volatile("" ::: "memory");
            }
    }
};
struct EpiKV {
    static constexpr bool PERM = true, ROWPERM = true, MIDK = false;
    bf16_t* KN; bf16_t* VT; const float* SSQ;
    __device__ __forceinline__ void operator()(const Acc& acc, const Unit& u, int wr, int wc, int fr, int fq) const {
        int tok0 = u.pm * 256 + 8 * (16 * wr + fr); const int h = u.pn;
        float rs[8];
#pragma unroll
        for (int j = 0; j < 8; ++j) { asm volatile("" : "+v"(tok0)); const f32x4* sp = (const f32x4*)(SSQ + (size_t)(tok0 + j) * 32 + 12); rs[j] = __builtin_amdgcn_rsqf((sum4(sp[0]) + sum4(sp[1])) * (1.f / 256.f) + EPS); }
        const int c0 = wc * 32 + 8 * fq;
#pragma unroll
        for (int ai = 0; ai < 2; ++ai)
#pragma unroll
            for (int m = 0; m < 4; ++m) { const int j = 4 * ai + m; asm volatile("" : "+v"(tok0));
                *(u32x4*)(KN + (size_t)(tok0 + j) * 512 + h * 128 + c0) = pack8(acc[ai][0][m][0] * rs[j], acc[ai][0][m][1] * rs[j]); asm volatile("" ::: "memory"); }
        const int b = tok0 >> 13, t0 = tok0 & 8191;
        bf16_t* vb = VT + ((size_t)(b * 4 + h) * 128 + c0) * 8192 + t0;
#pragma unroll
        for (int e = 0; e < 8; ++e) {
            const int n = e >> 2, k = e & 3; u32x4 w;
            w.x = pk2(acc[0][1][0][n][k] * rs[0], acc[0][1][1][n][k] * rs[1]); w.y = pk2(acc[0][1][2][n][k] * rs[2], acc[0][1][3][n][k] * rs[3]);
            w.z = pk2(acc[1][1][0][n][k] * rs[4], acc[1][1][1][n][k] * rs[5]); w.w = pk2(acc[1][1][2][n][k] * rs[6], acc[1][1][3][n][k] * rs[7]);
            *(u32x4*)(vb + (size_t)e * 8192) = w; asm volatile("" ::: "memory");
        }
    }
};
struct EpiS5a {
    static constexpr bool PERM = true, ROWPERM = false, MIDK = false;
    float* SB;
    __device__ __forceinline__ void operator()(const Acc& acc, const Unit& u, int wr, int wc, int fr, int fq) const {
        int rb = u.pm * 256 + wr * 64 + fr;
#pragma unroll
        for (int ai = 0; ai < 2; ++ai)
#pragma unroll
            for (int m = 0; m < 4; ++m) {
                asm volatile("" : "+v"(rb)); const int row = rb + ai * 128 + m * 16;
                float* p = SB + ((size_t)u.g * 4096 + row) * 128 + wc * 32 + 8 * fq;
                *(f32x4*)p = acc[ai][0][m][0]; *(f32x4*)(p + 4) = acc[ai][0][m][1];
            }
    }
};
struct EpiS5c {
    static constexpr bool PERM = true, ROWPERM = false, MIDK = false;
    bf16_t* Y; const bf16_t* UX; const float* Dk;
    __device__ __forceinline__ void operator()(const Acc& acc, const Unit& u, int wr, int wc, int fr, int fq) const {
        int rb = u.pm * 256 + wr * 64 + fr;
#pragma unroll
        for (int bj = 0; bj < 2; ++bj) {
            const int n0 = bj * 128 + wc * 32 + 8 * fq, i = n0 >> 4, h0 = n0 & 15;
#pragma unroll
            for (int ai = 0; ai < 2; ++ai)
#pragma unroll
                for (int m = 0; m < 4; ++m) {
                    asm volatile("" : "+v"(rb)); const int row = rb + ai * 128 + m * 16;
                    const u32x4 uu = *(const u32x4*)(UX + ((size_t)u.g * 4096 + row) * 384 + n0);
                    const f32x4 d0 = *(const f32x4*)(Dk + u.g * 16 + h0), d1 = *(const f32x4*)(Dk + u.g * 16 + h0 + 4);
                    f32x4 y0 = acc[ai][bj][m][0], y1 = acc[ai][bj][m][1];
                    y0[0] += d0[0] * bflo(uu.x); y0[1] += d0[1] * bfhi(uu.x); y0[2] += d0[2] * bflo(uu.y); y0[3] += d0[3] * bfhi(uu.y);
                    y1[0] += d1[0] * bflo(uu.z); y1[1] += d1[1] * bfhi(uu.z); y1[2] += d1[2] * bflo(uu.w); y1[3] += d1[3] * bfhi(uu.w);
#pragma unroll
                    for (int k = 0; k < 4; ++k) { y0[k] = gelu_t(y0[k]); y1[k] = gelu_t(y1[k]); }
                    const size_t tok = (size_t)(row >> 9) * 8192 + (size_t)(row & 511) * 16 + i;
                    *(u32x4*)(Y + tok * 512 + u.g * 16 + h0) = pack8(y0, y1); asm volatile("" ::: "memory");
                }
        }
    }
};
struct EpiGLU {
    static constexpr bool PERM = true, ROWPERM = false, MIDK = false;
    bf16_t* AS; float* SSQ; const float* bias;
    __device__ __forceinline__ void operator()(const Acc& acc, const Unit& u, int wr, int wc, int fr, int fq) const {
        int rb = u.pm * 256 + wr * 64 + fr;
        const int sc = u.pn * 128 + wc * 32 + 8 * fq;
        const f32x4 bv0 = *(const f32x4*)(bias + sc), bv1 = *(const f32x4*)(bias + sc + 4), bg0 = *(const f32x4*)(bias + 512 + sc), bg1 = *(const f32x4*)(bias + 512 + sc + 4);
#pragma unroll
        for (int ai = 0; ai < 2; ++ai)
#pragma unroll
            for (int m = 0; m < 4; ++m) {
                asm volatile("" : "+v"(rb)); const int row = rb + ai * 128 + m * 16;
                f32x4 o0, o1;
#pragma unroll
                for (int k = 0; k < 4; ++k) { o0[k] = (acc[ai][0][m][0][k] + bv0[k]) * sigmoid_f(acc[ai][1][m][0][k] + bg0[k]); o1[k] = (acc[ai][0][m][1][k] + bv1[k]) * sigmoid_f(acc[ai][1][m][1][k] + bg1[k]); }
                *(u32x4*)(AS + (size_t)row * 1024 + 512 + sc) = pack8(o0, o1);
                const float ss = red_fq(dot4(o0) + dot4(o1));
                if (fq == 0) SSQ[(size_t)row * 16 + u.pn * 4 + wc] = ss; asm volatile("" ::: "memory");
            }
    }
};
struct EpiRes {
    static constexpr bool PERM = true, ROWPERM = false, MIDK = false;
    const float* base; float* out; const float* gate; float* SSQ;
    __device__ __forceinline__ void operator()(const Acc& acc, const Unit& u, int wr, int wc, int fr, int fq) const {
        int rb = u.pm * 256 + wr * 64 + fr;
        const int b = u.pm >> 5;
#pragma unroll
        for (int bj = 0; bj < 2; ++bj) {
            const int c0 = u.pn * 256 + bj * 128 + wc * 32 + 8 * fq;
            const f32x4 g0 = *(const f32x4*)(gate + b * 6144 + c0), g1 = *(const f32x4*)(gate + b * 6144 + c0 + 4);
#pragma unroll
            for (int ai = 0; ai < 2; ++ai)
#pragma unroll
                for (int m = 0; m < 4; ++m) {
                    asm volatile("" : "+v"(rb)); const int row = rb + ai * 128 + m * 16;
                    const size_t off = (size_t)row * 1024 + c0;
                    const f32x4 x0 = *(const f32x4*)(base + off), x1 = *(const f32x4*)(base + off + 4);
                    const f32x4 o0 = x0 + g0 * acc[ai][bj][m][0], o1 = x1 + g1 * acc[ai][bj][m][1];
                    *(f32x4*)(out + off) = o0; *(f32x4*)(out + off + 4) = o1;
                    const float ss = red_fq(dot4(o0) + dot4(o1));
                    if (fq == 0) SSQ[(size_t)row * 32 + u.pn * 8 + bj * 4 + wc] = ss; asm volatile("" ::: "memory");
                }
        }
    }
};
struct EpiOut {
    static constexpr bool PERM = true, ROWPERM = false, MIDK = true;
    const float* base; float* out; const float* mod; const float* RST; bf16_t* H2o; const float* ln2; unsigned* xs; unsigned* cnt; LAS unsigned char* l2;
    __device__ __forceinline__ void mid(Acc& acc, const Unit& u, int wr, int wc, int fr, int fq) const {
        int rb = u.pm * 256 + wr * 64 + fr;
#pragma unroll
        for (int ai = 0; ai < 2; ++ai)
#pragma unroll
            for (int m = 0; m < 4; ++m) {
                asm volatile("" : "+v"(rb)); const float r = RST[(size_t)(rb + ai * 128 + m * 16) * 4];
                acc[ai][0][m][0] *= r; acc[ai][0][m][1] *= r; acc[ai][1][m][0] *= r; acc[ai][1][m][1] *= r;
            }
    }
    __device__ __forceinline__ void operator()(Acc& acc, const Unit& u, int wr, int wc, int fr, int fq) const {
        const int b = u.pm >> 5, lane = fq * 16 + fr, wid = wr * 4 + wc;
        LAS float* P = (LAS float*)l2; LAS float* S = (LAS float*)(l2 + 4096); LAS unsigned* flag = (LAS unsigned*)(l2 + 5120);
        int rb = u.pm * 256 + wr * 64 + fr;
#pragma unroll
        for (int ai = 0; ai < 2; ++ai)
#pragma unroll
            for (int m = 0; m < 4; ++m) {
                asm volatile("" : "+v"(rb)); const int row = rb + ai * 128 + m * 16;
                const float rss = RST[(size_t)row * 4 + 1];
                float s = 0.f;
#pragma unroll
                for (int bj = 0; bj < 2; ++bj) {
                    const int c0 = u.pn * 256 + bj * 128 + wc * 32 + 8 * fq; const size_t off = (size_t)row * 1024 + c0;
                    const f32x4 g0 = *(const f32x4*)(mod + b * 6144 + 2048 + c0), g1 = *(const f32x4*)(mod + b * 6144 + 2048 + c0 + 4);
                    const f32x4 x0 = *(const f32x4*)(base + off), x1 = *(const f32x4*)(base + off + 4);
                    acc[ai][bj][m][0] = x0 + g0 * (acc[ai][bj][m][0] * rss); acc[ai][bj][m][1] = x1 + g1 * (acc[ai][bj][m][1] * rss);
                    s += dot4(acc[ai][bj][m][0]) + dot4(acc[ai][bj][m][1]);
                }
                s = red_fq(s);
                if (fq == 0) P[(ai * 128 + wr * 64 + m * 16 + fr) * 4 + wc] = s;
                asm volatile("" ::: "memory");
            }
        asm volatile("s_waitcnt lgkmcnt(0)" ::: "memory"); __builtin_amdgcn_s_barrier(); asm volatile("" ::: "memory");
        const int prow = wid * 32 + (lane & 31);
        if (lane < 32) {
            const float tot = (P[prow * 4] + P[prow * 4 + 1]) + (P[prow * 4 + 2] + P[prow * 4 + 3]);
            __hip_atomic_store(xs + ((size_t)(u.pm * 256 + prow)) * 4 + u.pn, __float_as_uint(tot), __ATOMIC_RELAXED, __HIP_MEMORY_SCOPE_AGENT);
        }
        asm volatile("s_waitcnt vmcnt(0)" ::: "memory");
        if (lane == 0) __hip_atomic_fetch_add(cnt + 64 * u.pm, 1u, __ATOMIC_RELAXED, __HIP_MEMORY_SCOPE_AGENT);
        if (wid == 0) {
            unsigned spins = 0; bool dead = false;
            for (;;) {
                if ((unsigned)__builtin_amdgcn_readfirstlane(__hip_atomic_load(cnt + 64 * u.pm, __ATOMIC_RELAXED, __HIP_MEMORY_SCOPE_AGENT)) >= 32u) break;
                __builtin_amdgcn_s_sleep(2);
                if (++spins > (1u << 20)) { dead = true; break; }
            }
            __builtin_amdgcn_fence(__ATOMIC_ACQUIRE, "agent");
            if (lane == 0) flag[0] = dead ? 1u : 0u;
        }
        asm volatile("s_waitcnt vmcnt(0) lgkmcnt(0)" ::: "memory"); __builtin_amdgcn_s_barrier(); asm volatile("" ::: "memory");
        if (lane < 32) {
            const unsigned* sl = xs + ((size_t)(u.pm * 256 + prow)) * 4;
            float t = 0.f;
#pragma unroll
            for (int k = 0; k < 4; ++k) t += __uint_as_float(__hip_atomic_load(sl + k, __ATOMIC_RELAXED, __HIP_MEMORY_SCOPE_AGENT));
            S[prow] = __builtin_amdgcn_rsqf(t * (1.f / 1024.f) + EPS);
        }
        asm volatile("s_waitcnt vmcnt(0) lgkmcnt(0)" ::: "memory"); __builtin_amdgcn_s_barrier(); asm volatile("" ::: "memory");
        const float poison = flag[0] ? __builtin_nanf("") : 1.f;
#pragma unroll
        for (int bj = 0; bj < 2; ++bj) {
            const int c0 = u.pn * 256 + bj * 128 + wc * 32 + 8 * fq;
            const f32x4 cs0 = *(const f32x4*)(ln2 + c0) * (*(const f32x4*)(mod + b * 6144 + 4096 + c0) + 1.f), cs1 = *(const f32x4*)(ln2 + c0 + 4) * (*(const f32x4*)(mod + b * 6144 + 4096 + c0 + 4) + 1.f);
            const f32x4 sh0 = *(const f32x4*)(mod + b * 6144 + 3072 + c0), sh1 = *(const f32x4*)(mod + b * 6144 + 3072 + c0 + 4);
            rb = u.pm * 256 + wr * 64 + fr;
#pragma unroll
            for (int ai = 0; ai < 2; ++ai)
#pragma unroll
                for (int m = 0; m < 4; ++m) {
                    asm volatile("" : "+v"(rb)); const int row = rb + ai * 128 + m * 16; const size_t off = (size_t)row * 1024 + c0;
                    const float rs = S[ai * 128 + wr * 64 + m * 16 + fr] * poison;
                    const f32x4 o0 = acc[ai][bj][m][0], o1 = acc[ai][bj][m][1];
                    *(f32x4*)(out + off) = o0; *(f32x4*)(out + off + 4) = o1;
                    *(u32x4*)(H2o + off) = pack8(o0 * rs * cs0 + sh0, o1 * rs * cs1 + sh1);
                    asm volatile("" ::: "memory");
                }
        }
        asm volatile("s_waitcnt lgkmcnt(0)" ::: "memory"); __builtin_amdgcn_s_barrier(); asm volatile("" ::: "memory");
    }
};
struct EpiDownNorm {
    static constexpr bool PERM = true, ROWPERM = false, MIDK = false;
    const float* base; float* out; const float* gate; const float* fg; unsigned* xs; unsigned* cnt; LAS unsigned char* l2;
    __device__ __forceinline__ void operator()(Acc& acc, const Unit& u, int wr, int wc, int fr, int fq) const {
        const int b = u.pm >> 5, lane = fq * 16 + fr, wid = wr * 4 + wc;
        LAS float* P = (LAS float*)l2; LAS float* S = (LAS float*)(l2 + 4096); LAS unsigned* flag = (LAS unsigned*)(l2 + 5120);
        int rb = u.pm * 256 + wr * 64 + fr;
#pragma unroll
        for (int ai = 0; ai < 2; ++ai)
#pragma unroll
            for (int m = 0; m < 4; ++m) {
                asm volatile("" : "+v"(rb)); const int row = rb + ai * 128 + m * 16;
                float s = 0.f;
#pragma unroll
                for (int bj = 0; bj < 2; ++bj) {
                    const int c0 = u.pn * 256 + bj * 128 + wc * 32 + 8 * fq; const size_t off = (size_t)row * 1024 + c0;
                    const f32x4 g0 = *(const f32x4*)(gate + b * 6144 + c0), g1 = *(const f32x4*)(gate + b * 6144 + c0 + 4);
                    const f32x4 x0 = *(const f32x4*)(base + off), x1 = *(const f32x4*)(base + off + 4);
                    acc[ai][bj][m][0] = x0 + g0 * acc[ai][bj][m][0]; acc[ai][bj][m][1] = x1 + g1 * acc[ai][bj][m][1];
                    s += dot4(acc[ai][bj][m][0]) + dot4(acc[ai][bj][m][1]);
                }
                s = red_fq(s);
                if (fq == 0) P[(ai * 128 + wr * 64 + m * 16 + fr) * 4 + wc] = s;
                asm volatile("" ::: "memory");
            }
        asm volatile("s_waitcnt lgkmcnt(0)" ::: "memory"); __builtin_amdgcn_s_barrier(); asm volatile("" ::: "memory");
        const int prow = wid * 32 + (lane & 31);
        if (lane < 32) {
            const float tot = (P[prow * 4] + P[prow * 4 + 1]) + (P[prow * 4 + 2] + P[prow * 4 + 3]);
            __hip_atomic_store(xs + ((size_t)(u.pm * 256 + prow)) * 4 + u.pn, __float_as_uint(tot), __ATOMIC_RELAXED, __HIP_MEMORY_SCOPE_AGENT);
        }
        asm volatile("s_waitcnt vmcnt(0)" ::: "memory");
        if (lane == 0) __hip_atomic_fetch_add(cnt + 64 * u.pm, 1u, __ATOMIC_RELAXED, __HIP_MEMORY_SCOPE_AGENT);
        if (wid == 0) {
            unsigned spins = 0; bool dead = false;
            for (;;) {
                if ((unsigned)__builtin_amdgcn_readfirstlane(__hip_atomic_load(cnt + 64 * u.pm, __ATOMIC_RELAXED, __HIP_MEMORY_SCOPE_AGENT)) >= 32u) break;
                __builtin_amdgcn_s_sleep(2);
                if (++spins > (1u << 20)) { dead = true; break; }
            }
            __builtin_amdgcn_fence(__ATOMIC_ACQUIRE, "agent");
            if (lane == 0) flag[0] = dead ? 1u : 0u;
        }
        asm volatile("s_waitcnt vmcnt(0) lgkmcnt(0)" ::: "memory"); __builtin_amdgcn_s_barrier(); asm volatile("" ::: "memory");
        if (lane < 32) {
            const unsigned* sl = xs + ((size_t)(u.pm * 256 + prow)) * 4;
            float t = 0.f;
#pragma unroll
            for (int k = 0; k < 4; ++k) t += __uint_as_float(__hip_atomic_load(sl + k, __ATOMIC_RELAXED, __HIP_MEMORY_SCOPE_AGENT));
            S[prow] = __builtin_amdgcn_rsqf(t * (1.f / 1024.f) + EPS);
        }
        asm volatile("s_waitcnt vmcnt(0) lgkmcnt(0)" ::: "memory"); __builtin_amdgcn_s_barrier(); asm volatile("" ::: "memory");
        const float poison = flag[0] ? __builtin_nanf("") : 1.f;
        rb = u.pm * 256 + wr * 64 + fr;
#pragma unroll
        for (int ai = 0; ai < 2; ++ai)
#pragma unroll
            for (int m = 0; m < 4; ++m) {
                asm volatile("" : "+v"(rb)); const int row = rb + ai * 128 + m * 16;
                const float rs = S[ai * 128 + wr * 64 + m * 16 + fr] * poison;
#pragma unroll
                for (int bj = 0; bj < 2; ++bj) {
                    const int c0 = u.pn * 256 + bj * 128 + wc * 32 + 8 * fq; const size_t off = (size_t)row * 1024 + c0;
                    const f32x4 f0 = *(const f32x4*)(fg + c0), f1 = *(const f32x4*)(fg + c0 + 4);
                    *(f32x4*)(out + off) = acc[ai][bj][m][0] * rs * f0; *(f32x4*)(out + off + 4) = acc[ai][bj][m][1] * rs * f1;
                }
                asm volatile("" ::: "memory");
            }
        asm volatile("s_waitcnt lgkmcnt(0)" ::: "memory"); __builtin_amdgcn_s_barrier(); asm volatile("" ::: "memory");
    }
};
struct EpiUp {
    static constexpr bool PERM = true, ROWPERM = true, MIDK = false;
    bf16_t* ACT; float* HALO; float* FIX; const float* cw; const float* cb;
    __device__ __forceinline__ void operator()(const Acc& acc, const Unit& u, int wr, int wc, int fr, int fq) const {
        const int tok0 = u.pm * 256 + 8 * (16 * wr + fr), cg0 = u.pn * 128 + wc * 32 + 8 * fq;
        unsigned pk[8][4];
#pragma unroll
        for (int pp = 0; pp < 4; ++pp) {
            float a2[2][8];
#pragma unroll
            for (int q = 0; q < 2; ++q) {
                const int e = 2 * pp + q, n = e >> 2, k = e & 3, col = cg0 + e;
                const float w0 = cw[col], w1 = cw[DFF + col], w2 = cw[2 * DFF + col], bb = cb[col];
                float g[8], v[8];
#pragma unroll
                for (int j = 0; j < 8; ++j) { g[j] = acc[j >> 2][0][j & 3][n][k]; v[j] = acc[j >> 2][1][j & 3][n][k]; }
                const float p7 = __int_as_float(__builtin_amdgcn_update_dpp(__float_as_int(g[7]), __float_as_int(g[7]), 0x111, 0xf, 0xf, false)),
                            p6 = __int_as_float(__builtin_amdgcn_update_dpp(__float_as_int(g[6]), __float_as_int(g[6]), 0x111, 0xf, 0xf, false));
                a2[q][0] = gelu_t(bb + w0 * p6 + w1 * p7 + w2 * g[0]) * v[0];
                a2[q][1] = gelu_t(bb + w0 * p7 + w1 * g[0] + w2 * g[1]) * v[1];
#pragma unroll
                for (int j = 2; j < 8; ++j) a2[q][j] = gelu_t(bb + w0 * g[j - 2] + w1 * g[j - 1] + w2 * g[j]) * v[j];
                if (fr == 0) { float* f = FIX + ((size_t)(u.pm * 2 + wr) * 4) * DFF + col; f[0] = g[0]; f[DFF] = v[0]; f[2 * DFF] = g[1]; f[3 * DFF] = v[1]; }
                if (fr == 15) { float* hp = HALO + ((size_t)(u.pm * 2 + wr) * 2) * DFF + col; hp[0] = g[6]; hp[DFF] = g[7]; }
            }
#pragma unroll
            for (int j = 0; j < 8; ++j) pk[j][pp] = pk2(a2[0][j], a2[1][j]);
        }
#pragma unroll
        for (int j = 0; j < 8; ++j) {
            if (j < 2 && fr == 0) continue;
            u32x4 w; w.x = pk[j][0]; w.y = pk[j][1]; w.z = pk[j][2]; w.w = pk[j][3];
            *(u32x4*)(ACT + (size_t)(tok0 + j) * DFF + cg0) = w;
        }
    }
};

namespace att {
constexpr int KROW = 400, VROW = 144, KBUF = 64 * KROW, VBUF = 128 * VROW, OFF_V = 2 * KBUF, LDS_BYTES = OFF_V + 2 * VBUF;
__device__ __forceinline__ void attn_unit(int b, int h, int qb, const bf16_t* __restrict__ Q, const bf16_t* __restrict__ KN, const bf16_t* __restrict__ KR, const bf16_t* __restrict__ VT,
                                          bf16_t* AS, float* ASSQ, LAS unsigned char* lds) {
    int tid_ = threadIdx.x; asm volatile("" : "+v"(tid_));
    const int tid = tid_, lane = tid & 63, wid = __builtin_amdgcn_readfirstlane(tid >> 6), q = lane & 31, hi = lane >> 5;
    const size_t tokb = (size_t)b * 8192;
    const int qrel = wid * 32 + q, qrow = qb * 256 + qrel;
    bf16x8 qf[12];
    { const bf16_t* qp = Q + (tokb + qrow) * 768 + h * 192 + hi * 8;
#pragma unroll
      for (int s = 0; s < 12; ++s) qf[s] = *(const bf16x8*)(qp + s * 16); }
    const bf16_t* ksrc[3]; int kstr[3]; unsigned kdst[3];
#pragma unroll
    for (int i = 0; i < 3; ++i) { const int p = tid + 512 * i, key = p / 24, pc = p % 24;
        if (pc < 16) { ksrc[i] = KN + (tokb + key) * 512 + h * 128 + pc * 8; kstr[i] = 64 * 512; } else { ksrc[i] = KR + (tokb + key) * 64 + (pc - 16) * 8; kstr[i] = 64 * 64; }
        kdst[i] = (unsigned)(key * KROW + pc * 16); }
    const bf16_t* vsrc[2]; unsigned vdst[2];
#pragma unroll
    for (int i = 0; i < 2; ++i) { const int p = tid + 512 * i, dv = p >> 3, pc = p & 7; vsrc[i] = VT + ((size_t)(b * 4 + h) * 128 + dv) * 8192 + pc * 8; vdst[i] = (unsigned)(OFF_V + dv * VROW + pc * 16); }
    const int ntile = 4 * (qb + 1);
    u32x4 st[5];
#define ATT_LOAD(t) do { _Pragma("unroll") for (int i = 0; i < 3; ++i) st[i] = *(const u32x4*)(ksrc[i] + (size_t)(t) * kstr[i]); \
                         _Pragma("unroll") for (int i = 0; i < 2; ++i) st[3 + i] = *(const u32x4*)(vsrc[i] + (size_t)(t) * 64); } while (0)
#define ATT_WRITE(buf) do { _Pragma("unroll") for (int i = 0; i < 3; ++i) *(LAS u32x4*)(lds + (buf) * KBUF + kdst[i]) = st[i]; \
                            _Pragma("unroll") for (int i = 0; i < 2; ++i) *(LAS u32x4*)(lds + (buf) * VBUF + vdst[i]) = st[3 + i]; } while (0)
    ATT_LOAD(0); ATT_WRITE(0);
    const int i16 = q & 15;
    const int krow = 16 * (q >> 4) + 8 * ((i16 >> 2) & 1) + (i16 & 3) + 4 * (i16 >> 3);
    const unsigned kaddr = (unsigned)(krow * KROW + hi * 16), vaddr = (unsigned)(OFF_V + q * VROW + hi * 16);
    float mrun = 0.f, lrun = 0.f;
    f32x16 o[4], negm;
#pragma unroll
    for (int r = 0; r < 16; ++r) negm[r] = 0.f;
#pragma unroll
    for (int k = 0; k < 4; ++k)
#pragma unroll
        for (int r = 0; r < 16; ++r) o[k][r] = 0.f;
    for (int t = 0; t < ntile; ++t) {
        if (t + 1 < ntile) ATT_LOAD(t + 1);
        __syncthreads();
        const int jb = t - (ntile - 4);
        if (!(jb >= 0 && 64 * jb > 32 * wid + 31)) {
            const unsigned kb = (unsigned)((t & 1) * KBUF) + kaddr, vb = (unsigned)((t & 1) * VBUF) + vaddr;
            f32x16 p0, p1;
            __builtin_amdgcn_s_setprio(1);
            { const bf16x8 a0 = *(const LAS bf16x8*)(lds + kb), a1 = *(const LAS bf16x8*)(lds + kb + 32 * KROW);
              p0 = __builtin_amdgcn_mfma_f32_32x32x16_bf16(a0, qf[0], negm, 0, 0, 0);
              p1 = __builtin_amdgcn_mfma_f32_32x32x16_bf16(a1, qf[0], negm, 0, 0, 0); }
#pragma unroll
            for (int s = 1; s < 12; ++s) {
                const bf16x8 a0 = *(const LAS bf16x8*)(lds + kb + s * 32), a1 = *(const LAS bf16x8*)(lds + kb + 32 * KROW + s * 32);
                p0 = __builtin_amdgcn_mfma_f32_32x32x16_bf16(a0, qf[s], p0, 0, 0, 0);
                p1 = __builtin_amdgcn_mfma_f32_32x32x16_bf16(a1, qf[s], p1, 0, 0, 0);
            }
            __builtin_amdgcn_s_setprio(0);
            if (jb >= 0) {
#pragma unroll
                for (int r = 0; r < 16; ++r) { const int kp = 64 * jb + 16 * (r >> 3) + 8 * hi + (r & 7);
                    if (kp > qrel) p0[r] = -INFINITY; if (kp + 32 > qrel) p1[r] = -INFINITY; }
            }
            float mx, mx2;
            asm("v_max3_f32 %0, %1, %2, %3" : "=v"(mx) : "v"(p0[0]), "v"(p1[0]), "v"(p0[1]));
            asm("v_max3_f32 %0, %1, %2, %3" : "=v"(mx2) : "v"(p1[1]), "v"(p0[2]), "v"(p1[2]));
#pragma unroll
            for (int r = 3; r < 15; r += 2) { asm("v_max3_f32 %0, %1, %2, %3" : "=v"(mx) : "v"(mx), "v"(p0[r]), "v"(p1[r])); asm("v_max3_f32 %0, %1, %2, %3" : "=v"(mx2) : "v"(mx2), "v"(p0[r + 1]), "v"(p1[r + 1])); }
            asm("v_max3_f32 %0, %1, %2, %3" : "=v"(mx) : "v"(mx), "v"(p0[15]), "v"(p1[15]));
            mx = fmaxf(mx, mx2);
            mx = fmaxf(mx, __shfl_xor(mx, 32));
            if (t == 0) {
                mrun = mx;
#pragma unroll
                for (int r = 0; r < 16; ++r) { p0[r] -= mx; p1[r] -= mx; negm[r] = -mx; }
            } else if (__any(mx > 8.f)) {
                const float d = fmaxf(mx, 0.f), f = __builtin_amdgcn_exp2f(-d);
                mrun += d; lrun *= f;
#pragma unroll
                for (int r = 0; r < 16; ++r) { p0[r] -= d; p1[r] -= d; negm[r] = -mrun; }
#pragma unroll
                for (int k = 0; k < 4; ++k)
#pragma unroll
                    for (int r = 0; r < 16; ++r) o[k][r] *= f;
            }
            float rs = 0.f, rs2 = 0.f, one = 1.f;
            asm volatile("" : "+v"(one));
#pragma unroll
            for (int r = 0; r < 16; ++r) { p0[r] = __builtin_amdgcn_exp2f(p0[r]); p1[r] = __builtin_amdgcn_exp2f(p1[r]); rs = __builtin_fmaf(p0[r], one, rs); rs2 = __builtin_fmaf(p1[r], one, rs2); }
            lrun += rs + rs2;
            bf16x8 pb[4];
            { u32x4 w;
              w.x = pk2(p0[0], p0[1]); w.y = pk2(p0[2], p0[3]); w.z = pk2(p0[4], p0[5]); w.w = pk2(p0[6], p0[7]); pb[0] = __builtin_bit_cast(bf16x8, w);
              w.x = pk2(p0[8], p0[9]); w.y = pk2(p0[10], p0[11]); w.z = pk2(p0[12], p0[13]); w.w = pk2(p0[14], p0[15]); pb[1] = __builtin_bit_cast(bf16x8, w);
              w.x = pk2(p1[0], p1[1]); w.y = pk2(p1[2], p1[3]); w.z = pk2(p1[4], p1[5]); w.w = pk2(p1[6], p1[7]); pb[2] = __builtin_bit_cast(bf16x8, w);
              w.x = pk2(p1[8], p1[9]); w.y = pk2(p1[10], p1[11]); w.z = pk2(p1[12], p1[13]); w.w = pk2(p1[14], p1[15]); pb[3] = __builtin_bit_cast(bf16x8, w); }
            __builtin_amdgcn_s_setprio(1);
#pragma unroll
            for (int k = 0; k < 4; ++k)
#pragma unroll
                for (int ks = 0; ks < 4; ++ks) {
                    const bf16x8 va = *(const LAS bf16x8*)(lds + vb + k * 32 * VROW + ks * 32);
                    o[k] = __builtin_amdgcn_mfma_f32_32x32x16_bf16(va, pb[ks], o[k], 0, 0, 0);
                }
            __builtin_amdgcn_s_setprio(0);
        }
        if (t + 1 < ntile) ATT_WRITE((t + 1) & 1);
    }
#undef ATT_LOAD
#undef ATT_WRITE
    const float ltot = lrun + __shfl_xor(lrun, 32), inv = 1.f / ltot;
    float ss = 0.f;
    bf16_t* op = AS + (tokb + qrow) * 1024 + h * 128 + 4 * hi;
#pragma unroll
    for (int k = 0; k < 4; ++k)
#pragma unroll
        for (int rg = 0; rg < 4; ++rg) {
            const float v0 = o[k][4 * rg] * inv, v1 = o[k][4 * rg + 1] * inv, v2 = o[k][4 * rg + 2] * inv, v3 = o[k][4 * rg + 3] * inv;
            ss += (v0 * v0 + v1 * v1) + (v2 * v2 + v3 * v3);
            u32x2 w; w.x = pk2(v0, v1); w.y = pk2(v2, v3);
            *(u32x2*)(op + 32 * k + 8 * rg) = w;
        }
    ss += __shfl_xor(ss, 32);
    if (hi == 0) ASSQ[(tokb + qrow) * 4 + h] = ss;
    __syncthreads();
}
}


#define XB_TMO      128
#define XB_XCNT(j)  (256  + 64 * (j))
#define XB_XSUB(j)  (1280 + 64 * (j))
#define XB_XGEN(j)  (2304 + 64 * (j))
#define XB_TOP      3328
#define XB_TOPGEN   3392
#define XCD_BAR_WORDS 3456
#define XB_SPIN_CAP (1u << 18)
__device__ __forceinline__ unsigned xb_ld(unsigned* p)              { return __hip_atomic_load(p, __ATOMIC_RELAXED, __HIP_MEMORY_SCOPE_AGENT); }
__device__ __forceinline__ unsigned xb_add(unsigned* p, unsigned v) { return __hip_atomic_fetch_add(p, v, __ATOMIC_RELAXED, __HIP_MEMORY_SCOPE_AGENT); }
__device__ __forceinline__ unsigned xb_xcc_id() { return (unsigned)__builtin_amdgcn_s_getreg((3 << 11) | 20) & 0xFu; }
#define XB_SPIN(cond, bar) do { unsigned _sp = 0; while (cond) { __builtin_amdgcn_s_sleep(1); \
    if ((++_sp & 255u) == 0u) { if (xb_ld(&(bar)[XB_TMO])) break; if (_sp > XB_SPIN_CAP) { atomicAdd(&(bar)[XB_TMO], 1u); break; } } } } while (0)
struct XcdBarrier { unsigned* bar; unsigned x; volatile LAS unsigned* st; };
__device__ __forceinline__ XcdBarrier xcd_barrier_post(unsigned* bar, volatile LAS unsigned* st) {
    XcdBarrier b; b.bar = bar; b.x = xb_xcc_id(); b.st = st;
    if (threadIdx.x == 0) (void)xb_add(&bar[XB_XCNT(b.x)], 1u);
    return b;
}
__device__ __forceinline__ void xcd_barrier_complete(unsigned* bar, unsigned x, unsigned& nloc, unsigned& nx) {
    const unsigned G = gridDim.x * gridDim.y * gridDim.z;
    unsigned sum, cnt, mine, sp = 0u;
    for (;;) {
        sum = 0u; cnt = 0u; mine = 0u;
#pragma unroll
        for (unsigned j = 0; j < 16; ++j) { const unsigned c = xb_ld(&bar[XB_XCNT(j)]); sum += c; cnt += (c > 0u) ? 1u : 0u; mine = (j == x) ? c : mine; }
        if (sum == G) break;
        __builtin_amdgcn_s_sleep(1);
        if ((++sp & 255u) == 0u) { if (xb_ld(&bar[XB_TMO])) break; if (sp > XB_SPIN_CAP) { atomicAdd(&bar[XB_TMO], 1u); break; } }
    }
    nloc = mine > 0u ? mine : 1u; nx = cnt > 0u ? cnt : 1u;
}
__device__ __forceinline__ void xcd_barrier(const XcdBarrier& b) {
    asm volatile("s_waitcnt vmcnt(0)" ::: "memory");
    __syncthreads();
    if (threadIdx.x == 0) {
        unsigned* bar = b.bar;
        __builtin_amdgcn_s_waitcnt(0);
        unsigned nloc = b.st[0], nx = b.st[1];
        if (nloc == 0u) { xcd_barrier_complete(bar, b.x, nloc, nx); b.st[0] = nloc; b.st[1] = nx; }
        const unsigned old = xb_add(&bar[XB_XSUB(b.x)], 1u);
        const unsigned gen = old / nloc;
        if (old + 1u == (gen + 1u) * nloc) {
            __builtin_amdgcn_fence(__ATOMIC_RELEASE, "agent");
            asm volatile("s_waitcnt vmcnt(0)" ::: "memory");
            const unsigned og = xb_add(&bar[XB_TOP], 1u);
            const unsigned tg = og / nx;
            if (og + 1u == (tg + 1u) * nx) xb_add(&bar[XB_TOPGEN], 1u);
            else XB_SPIN(xb_ld(&bar[XB_TOPGEN]) == tg, bar);
            __builtin_amdgcn_fence(__ATOMIC_ACQUIRE, "agent");
            xb_add(&bar[XB_XGEN(b.x)], 1u);
            asm volatile("s_waitcnt vmcnt(0)" ::: "memory");
        } else {
            XB_SPIN(xb_ld(&bar[XB_XGEN(b.x)]) == gen, bar);
            __builtin_amdgcn_fence(__ATOMIC_ACQUIRE, "agent");
            asm volatile("s_waitcnt vmcnt(0)" ::: "memory");
        }
    }
    __syncthreads();
}
struct Args { const void* in[30]; float* out; unsigned char* ws; };

__device__ __forceinline__ void blk_sync_mem() { __threadfence_block(); __syncthreads(); }

template <class SrcCol, class KScale>
__device__ __forceinline__ void transpose_item(const float* __restrict__ W, int K, int N, bf16_t* WT, int nout, LAS float* scr, int item, int lane, SrcCol sc, KScale ks) {
    const int nblk = nout / 32, kb = item / nblk, nb = item % nblk, k0 = 64 * kb, n0 = 32 * nb;
    const int src = sc(n0 + (lane & 31));
#pragma unroll 8
    for (int i = 0; i < 32; ++i) { const int kk = 2 * i + (lane >> 5); scr[kk * 33 + (lane & 31)] = src >= 0 ? W[(size_t)(k0 + kk) * N + src] * ks(k0 + kk) : 0.f; }
    asm volatile("s_waitcnt lgkmcnt(0)" ::: "memory");
    const int c = lane & 7;
#pragma unroll
    for (int j = 0; j < 4; ++j) { const int n = (lane >> 3) + 8 * j; const LAS float* s = scr + (8 * c) * 33 + n;
        u32x4 o; o.x = pk2(s[0 * 33], s[1 * 33]); o.y = pk2(s[2 * 33], s[3 * 33]); o.z = pk2(s[4 * 33], s[5 * 33]); o.w = pk2(s[6 * 33], s[7 * 33]);
        *(u32x4*)(WT + (size_t)(n0 + n) * K + k0 + 8 * c) = o; }
    asm volatile("s_waitcnt lgkmcnt(0)" ::: "memory");
}
__device__ __forceinline__ void cpowd(double lrdt, double lidt, int e, double& re, double& im) { const double mag = exp(lrdt * e), a = lidt * e; re = mag * cos(a); im = mag * sin(a); }

__device__ __forceinline__ const float* ldarg(int i) {
    const __attribute__((address_space(4))) char* kp = (const __attribute__((address_space(4))) char*)__builtin_amdgcn_kernarg_segment_ptr();
    int off = i * 8; asm volatile("" : "+s"(off));
    return *(const float* const __attribute__((address_space(4)))*)(kp + off);
}
#define WT_in ((bf16_t*)(ws + WS_WIN))
#define WT_uq ((bf16_t*)(ws + WS_WUQ))
#define WT_ukv ((bf16_t*)(ws + WS_WUKV))
#define WT_glu ((bf16_t*)(ws + WS_WGLU))
#define WT_out ((bf16_t*)(ws + WS_WOUT))
#define WT_up ((bf16_t*)(ws + WS_WUP))
#define WT_down ((bf16_t*)(ws + WS_WDOWN))
#define WS5S ((bf16_t*)(ws + WS_WS5S))
#define WS5T ((bf16_t*)(ws + WS_WS5T))
#define MOD ((float*)(ws + WS_MOD))
#define A16 ((f32x2*)(ws + WS_MOD + 512 * 1024))
#define CS ((f32x2*)(ws + WS_CS))
#define SSQ1 ((float*)(ws + WS_SSQ1))
#define ASSQ ((float*)(ws + WS_ASSQ))
#define SSQ2 ((float*)(ws + WS_SSQ2))
#define SSQ3 ((float*)(ws + WS_SSQ3))
#define SSQ4 ((float*)(ws + WS_SSQ4))
#define HALO ((float*)(ws + WS_HALO))
#define FIX ((float*)(ws + WS_FIX))
#define YSSM ((bf16_t*)(ws + WS_YSSM))
#define AS ((bf16_t*)(ws + WS_AS))
#define H1 ((bf16_t*)(ws + WS_H1))
#define Z ((bf16_t*)(ws + WS_Z))
#define UX ((bf16_t*)(ws + WS_UX))
#define SB ((float*)(ws + WS_SB))
#define Qb ((bf16_t*)(ws + WS_Q))
#define KN ((bf16_t*)(ws + WS_KN))
#define VT ((bf16_t*)(ws + WS_VT))
#define KR ((bf16_t*)(ws + WS_KR))
#define H2 ((bf16_t*)(ws + WS_H2))
#define RST ((float*)(ws + WS_RST))
#define ACT ((bf16_t*)(ws + WS_ACT))
#define PHASE_IDS int tid_l = threadIdx.x; asm volatile("" : "+v"(tid_l)); const int tid = tid_l, lane = tid & 63, wid = __builtin_amdgcn_readfirstlane(tid >> 6), gw = bx * 8 + wid; (void)gw; (void)lane; (void)tid;
__global__ void __launch_bounds__(512, 2) fwd_kernel(Args a) {
    extern __shared__ __attribute__((aligned(16))) unsigned char lds_raw[];
    LAS unsigned char* lds = (LAS unsigned char*)lds_raw;
    cg::grid_group grid = cg::this_grid();
    const int tid = threadIdx.x, lane = tid & 63, wid = __builtin_amdgcn_readfirstlane(tid >> 6);
    const int G = gridDim.x, bx = blockIdx.x, gw = bx * 8 + wid, NGW = G * 8;
    volatile LAS unsigned* bst = (volatile LAS unsigned*)(lds + 139264);
    if (tid < 4) bst[tid] = 0u;
    __syncthreads();
    const XcdBarrier xbar = xcd_barrier_post((unsigned*)(a.ws + WS_BAR), bst);
    float* const out = a.out; unsigned char* const ws = a.ws;
#if PHM & 1
    { PHASE_IDS
    REP(1) {
        LAS float* cond = (LAS float*)lds;
        LAS float* red = (LAS float*)(lds + 32768);
        const float* cvec = ldarg(1); const float* w_mod = ldarg(3); const float* b_mod = ldarg(4);
        for (int cb = bx; cb < 96; cb += G) {
            for (int i = tid; i < 8192; i += 512) { const float v = cvec[i]; cond[i] = v * sigmoid_f(v); }
            __syncthreads();
            float accb[8];
#pragma unroll
            for (int b = 0; b < 8; ++b) accb[b] = 0.f;
            const int col = cb * 64 + lane;
#pragma unroll 8
            for (int k = wid * 128; k < wid * 128 + 128; ++k) { const float wv = w_mod[(size_t)k * 6144 + col];
#pragma unroll
                for (int b = 0; b < 8; ++b) accb[b] += cond[b * 1024 + k] * wv; }
#pragma unroll
            for (int b = 0; b < 8; ++b) red[(wid * 8 + b) * 64 + lane] = accb[b];
            __syncthreads();
            { float s = b_mod[col];
#pragma unroll
              for (int w = 0; w < 8; ++w) s += red[(w * 8 + wid) * 64 + lane];
              MOD[wid * 6144 + col] = s; }
            __syncthreads();
        }
        __syncthreads();
        LAS float* scr = (LAS float*)(lds + wid * 16384);
        constexpr int I_IN = 16 * 40, I_UQ = 6 * 24, I_UKV = 4 * 32, I_GLU = 8 * 32, I_OUT = 16 * 32, I_UP = 16 * 176, I_DOWN = 44 * 32, I_S5 = 512;
        constexpr int NITEMS = I_IN + I_UQ + I_UKV + I_GLU + I_OUT + I_UP + I_DOWN + I_S5;
        for (int it = gw; it < NITEMS; it += NGW) {
            int r = it;
            if (r < I_S5) {
                const int g = r >> 4, d = r & 15, p = lane;
                const float* lam_re = ldarg(11); const float* lam_im = ldarg(12); const float* log_dt = ldarg(13); const float* b_re = ldarg(14); const float* b_im = ldarg(15); const float* c_re = ldarg(16); const float* c_im = ldarg(17);
                const double lr = (double)fminf(lam_re[g * 64 + p], -1e-4f), li = (double)lam_im[g * 64 + p], dt = exp((double)log_dt[g]);
                const double lrdt = lr * dt, lidt = li * dt;
                double are, aim; cpowd(lrdt, lidt, 1, are, aim);
                const double nr = are - 1.0, ni = aim, den = lr * lr + li * li;
                const double zre = (nr * lr + ni * li) / den, zim = (ni * lr - nr * li) / den;
                double e_re, e_im;
                cpowd(lrdt, lidt, d, e_re, e_im);
                scr[p] = (float)(e_re * zre - e_im * zim); scr[64 + p] = (float)(e_re * zim + e_im * zre);
                asm volatile("s_waitcnt lgkmcnt(0)" ::: "memory");
                bf16_t* Tg = WS5T + (size_t)g * 256 * 384; bf16_t* Sg = WS5S + (size_t)g * 256 * 256;
#pragma unroll 1
                for (int k4 = 0; k4 < 4; ++k4) {
                    const int idx = lane + 64 * k4, h = idx >> 4, hp = idx & 15;
                    float s = 0.f;
                    for (int pp = 0; pp < 64; ++pp) {
                        const float Cr = c_re[(g * 16 + h) * 64 + pp], Ci = c_im[(g * 16 + h) * 64 + pp], Br = b_re[(g * 64 + pp) * 16 + hp], Bi = b_im[(g * 64 + pp) * 16 + hp];
                        const float Wr = scr[pp], Wi = scr[64 + pp];
                        s += (Cr * Wr - Ci * Wi) * Br - (Cr * Wi + Ci * Wr) * Bi;
                    }
                    const bf16_t kv = (bf16_t)(pk2(s, 0.f) & 0xffffu);
                    for (int i = d; i < 16; ++i) Tg[(size_t)(i * 16 + h) * 384 + (i - d) * 16 + hp] = kv;
                    if (d >= 1) for (int i = 0; i + d < 16; ++i) Tg[(size_t)(i * 16 + h) * 384 + (i + d) * 16 + hp] = 0;
                }
                cpowd(lrdt, lidt, d + 1, e_re, e_im);
                for (int h = 0; h < 16; ++h) { const double Cr = c_re[(g * 16 + h) * 64 + p], Ci = c_im[(g * 16 + h) * 64 + p];
                    Tg[(size_t)(d * 16 + h) * 384 + 256 + p] = (bf16_t)(pk2((float)(Cr * e_re - Ci * e_im), 0.f) & 0xffffu);
                    Tg[(size_t)(d * 16 + h) * 384 + 320 + p] = (bf16_t)(pk2((float)(-(Cr * e_im + Ci * e_re)), 0.f) & 0xffffu); }
                cpowd(lrdt, lidt, 15 - d, e_re, e_im);
                { const double fr_ = e_re * zre - e_im * zim, fi_ = e_re * zim + e_im * zre;
                  for (int hp = 0; hp < 16; ++hp) { const double Br = b_re[(g * 64 + p) * 16 + hp], Bi = b_im[(g * 64 + p) * 16 + hp];
                      Sg[(size_t)p * 256 + d * 16 + hp] = (bf16_t)(pk2((float)(fr_ * Br - fi_ * Bi), 0.f) & 0xffffu);
                      Sg[(size_t)(64 + p) * 256 + d * 16 + hp] = (bf16_t)(pk2((float)(fr_ * Bi + fi_ * Br), 0.f) & 0xffffu);
                      Sg[(size_t)(128 + p) * 256 + d * 16 + hp] = 0; Sg[(size_t)(192 + p) * 256 + d * 16 + hp] = 0; } }
                if (d == 0) { cpowd(lrdt, lidt, 16, e_re, e_im); A16[g * 64 + p] = (f32x2){(float)e_re, (float)e_im}; }
                asm volatile("s_waitcnt lgkmcnt(0)" ::: "memory");
                continue;
            }
            r -= I_S5;
            auto one = [](int) { return 1.f; };
            if (r < I_IN) { transpose_item(ldarg(6), 1024, NIN, WT_in, NINP, scr, r, lane,
                [](int n) { return n >= NIN ? -1 : (n >= 640 && n < 704) ? 640 + ((n - 640) >> 1) + 32 * ((n - 640) & 1) : n; }, one); continue; } r -= I_IN;
            if (r < I_UQ) { const float* q_norm_g = ldarg(7); transpose_item(ldarg(8), 384, 768, WT_uq, 768, scr, r, lane,
                [](int n) { const int hh = n / 192, w = n % 192; return w < 128 ? n : hh * 192 + 128 + ((w - 128) >> 1) + 32 * ((w - 128) & 1); }, [=](int k) { return q_norm_g[k]; }); continue; } r -= I_UQ;
            if (r < I_UKV) { const float* kv_norm_g = ldarg(9); transpose_item(ldarg(10), 256, 1024, WT_ukv, 1024, scr, r, lane, [](int n) { return n; }, [=](int k) { return kv_norm_g[k]; }); continue; } r -= I_UKV;
            if (r < I_GLU) { transpose_item(ldarg(19), 512, 1024, WT_glu, 1024, scr, r, lane, [](int n) { return 512 * ((n >> 7) & 1) + 128 * (n >> 8) + (n & 127); }, one); continue; } r -= I_GLU;
            if (r < I_OUT) { const float* attn_out_g = ldarg(21); const float* ssm_out_g = ldarg(22); transpose_item(ldarg(23), 1024, 1024, WT_out, 1024, scr, r, lane, [](int n) { return n; }, [=](int k) { return k < 512 ? attn_out_g[k] : ssm_out_g[k - 512]; }); continue; } r -= I_OUT;
            if (r < I_UP) { transpose_item(ldarg(25), 1024, 2 * DFF, WT_up, 2 * DFF, scr, r, lane, [](int n) { return DFF * ((n >> 7) & 1) + 128 * (n >> 8) + (n & 127); }, one); continue; } r -= I_UP;
            transpose_item(ldarg(28), DFF, 1024, WT_down, 1024, scr, r, lane, [](int n) { return n; }, one);
        }
        {
            LAS double* invf = (LAS double*)lds;
            __syncthreads();
            if (tid < 32) invf[tid] = exp2(-(double)tid * (13.287712379549449 / 32.0)) * 0.15915494309189535;
            __syncthreads();
            const int* pos = (const int*)ldarg(2);
            for (size_t i = (size_t)bx * 512 + tid; i < (size_t)NT * 32; i += (size_t)G * 512) {
                const int t = (int)(i >> 5), f = (int)(i & 31);
                double rv = (double)pos[t] * invf[f]; rv -= rint(rv);
                const float fr = (float)rv;
                CS[i] = (f32x2){__builtin_amdgcn_cosf(fr), __builtin_amdgcn_sinf(fr)};
            }
        }
        __syncthreads();
    }
    grid.sync();

    }
#endif
#if PHM & 2
    { PHASE_IDS
    REP(2) { const float* x = ldarg(0); const float* ln1_g = ldarg(5);
    for (int ch = gw; ch < NT / 32; ch += NGW) {
        const int b = (ch * 32) >> 13;
        f32x4 cs[4], sh[4];
#pragma unroll
        for (int j = 0; j < 4; ++j) { const int c0 = 4 * lane + 256 * j; const f32x4 gg = *(const f32x4*)(ln1_g + c0), sc = *(const f32x4*)(MOD + b * 6144 + 1024 + c0);
            cs[j] = gg * (sc + 1.f); sh[j] = *(const f32x4*)(MOD + b * 6144 + c0); }
        for (int rr = 0; rr < 32; ++rr) {
            const size_t row = (size_t)ch * 32 + rr;
            const f32x4* xr = (const f32x4*)(x + row * 1024) + lane;
            f32x4 v[4]; float s = 0.f;
#pragma unroll
            for (int j = 0; j < 4; ++j) { v[j] = xr[64 * j]; s += dot4(v[j]); }
            const float rstd = __builtin_amdgcn_rsqf(wave_sum(s) * (1.f / 1024.f) + EPS);
            u32x2* o8 = (u32x2*)(H1 + row * 1024) + lane;
#pragma unroll
            for (int j = 0; j < 4; ++j) { const f32x4 y = v[j] * rstd * cs[j] + sh[j]; u32x2 w; w.x = pk2(y[0], y[1]); w.y = pk2(y[2], y[3]); o8[64 * j] = w; }
        }
    }
    }
    xcd_barrier(xbar);

    }
#endif
#if PHM & 4
    { PHASE_IDS
    REP(4) {
        pg8::Gemm g{H1, WT_in, 1024, 1024}; pg8::StaticOrder S; S.init(256, 5, G, bx, (size_t)256 * 1024 * 2, (size_t)256 * 1024 * 2);
        Epi1 E{Z, KR, UX, SSQ1, CS};
        pg8::gemm_phase(lds, g, S, E);
    }
    xcd_barrier(xbar);

    }
#endif
#if PHM & 8
    { PHASE_IDS
    REP(8) {
#if P3SEL & 1
        { pg8::Gemm g{Z, WT_uq, 384, 640}; pg8::StaticOrder S; S.init(256, 3, G, bx, (size_t)256 * 640 * 2, (size_t)256 * 384 * 2); EpiQ E{Qb, SSQ1, CS}; pg8::gemm_phase(lds, g, S, E); }
#endif
#if P3SEL & 2
        { pg8::Gemm g{Z + 384, WT_ukv, 256, 640}; pg8::StaticOrder S; S.init(256, 4, G, bx, (size_t)256 * 640 * 2, (size_t)256 * 256 * 2); EpiKV E{KN, VT, SSQ1}; pg8::gemm_phase(lds, g, S, E); }
#endif
#if P3SEL & 4
        for (int bg = bx; bg < 256; bg += G) { pg8::Gemm g{UX, WS5S, 256, 384}; pg8::BGOrder S{bg & 7, bg >> 3, (size_t)4096 * 384 * 2, (size_t)256 * 256 * 2, (size_t)256 * 384 * 2}; EpiS5a E{SB}; pg8::gemm_phase(lds, g, S, E); }
#endif
    }
    xcd_barrier(xbar);

    }
#endif
#if PHM & 16
    { PHASE_IDS
#if P4SEL & 1
    REP(16) for (int bg = bx; bg < 256; bg += G) {
        const int b = bg & 7, g = bg >> 3;
        {
            const int p = lane; const f32x2 A = A16[g * 64 + p];
            const float* sb = SB + ((size_t)g * 4096 + b * 512 + 64 * wid) * 128; bf16_t* ux = UX + ((size_t)g * 4096 + b * 512 + 64 * wid) * 384 + 256;
            LAS float* ex = (LAS float*)lds;
            float xr = 0.f, xi = 0.f;
            for (int c0 = 0; c0 < 64; c0 += 8) {
                float sr[8], si[8];
#pragma unroll
                for (int k = 0; k < 8; ++k) { sr[k] = sb[(size_t)(c0 + k) * 128 + p]; si[k] = sb[(size_t)(c0 + k) * 128 + 64 + p]; }
#pragma unroll
                for (int k = 0; k < 8; ++k) { const float nr = A.x * xr - A.y * xi + sr[k], ni = A.x * xi + A.y * xr + si[k]; xr = nr; xi = ni; }
            }
            ex[wid * 128 + p] = xr; ex[wid * 128 + 64 + p] = xi;
            __syncthreads();
            float ar = A.x, ai = A.y;
#pragma unroll
            for (int k = 0; k < 6; ++k) { const float nr = ar * ar - ai * ai, ni = 2.f * ar * ai; ar = nr; ai = ni; }
            xr = 0.f; xi = 0.f;
            for (int v = 0; v < wid; ++v) { const float er = ex[v * 128 + p], ei = ex[v * 128 + 64 + p]; const float nr = ar * xr - ai * xi + er, ni = ar * xi + ai * xr + ei; xr = nr; xi = ni; }
            for (int c0 = 0; c0 < 64; c0 += 8) {
                float sr[8], si[8];
#pragma unroll
                for (int k = 0; k < 8; ++k) { sr[k] = sb[(size_t)(c0 + k) * 128 + p]; si[k] = sb[(size_t)(c0 + k) * 128 + 64 + p]; }
#pragma unroll
                for (int k = 0; k < 8; ++k) {
                    ux[(size_t)(c0 + k) * 384 + p] = (bf16_t)(pk2(xr, 0.f) & 0xffffu); ux[(size_t)(c0 + k) * 384 + 64 + p] = (bf16_t)(pk2(xi, 0.f) & 0xffffu);
                    const float nr = A.x * xr - A.y * xi + sr[k], ni = A.x * xi + A.y * xr + si[k]; xr = nr; xi = ni;
                }
            }
        }
        blk_sync_mem();
        pg8::Gemm gm{UX, WS5T, 384, 384}; pg8::BGOrder S{b, g, (size_t)4096 * 384 * 2, (size_t)256 * 384 * 2, (size_t)256 * 384 * 2}; EpiS5c E{YSSM, UX, ldarg(18)};
        pg8::gemm_phase(lds, gm, S, E);
    }
#endif
    __syncthreads();
#if P4SEL & 2
    REP(32) for (int v = bx; v < 256; v += G) {
        const int vv = (v & 7) * 32 + (v >> 3);
        const int bh = vv >> 3, s = vv & 7;
#pragma unroll 1
        for (int i = 0; i < 4; ++i) { const int qb = (i == 0) ? s : (i == 1) ? 15 - s : (i == 2) ? 16 + s : 31 - s;
            att::attn_unit(bh >> 2, bh & 3, qb, Qb, KN, KR, VT, AS, ASSQ, lds); }
    }
#endif
    xcd_barrier(xbar);

    }
#endif
#if PHM & 32
    { PHASE_IDS
    REP(128) { pg8::Gemm g{YSSM, WT_glu, 512, 512}; pg8::StaticOrder S; S.init(256, 4, G, bx, (size_t)256 * 512 * 2, (size_t)256 * 512 * 2); EpiGLU E{AS, SSQ2, ldarg(20)}; pg8::gemm_phase(lds, g, S, E); }
    xcd_barrier(xbar);
    for (int row = bx * 512 + tid; row < NT; row += G * 512) {
        const f32x4 sa = *(const f32x4*)(ASSQ + (size_t)row * 4); const f32x4* sp = (const f32x4*)(SSQ2 + (size_t)row * 16);
        const float rsa = __builtin_amdgcn_rsqf(sum4(sa) * (1.f / 512.f) + EPS), rss = __builtin_amdgcn_rsqf((sum4(sp[0]) + sum4(sp[1]) + sum4(sp[2]) + sum4(sp[3])) * (1.f / 512.f) + EPS);
        RST[(size_t)row * 4] = rsa / rss; RST[(size_t)row * 4 + 1] = rss;
    }
    xcd_barrier(xbar);
    REP(128) { pg8::Gemm g{AS, WT_out, 1024, 1024}; pg8::StaticOrder S; S.init(256, 4, G, bx, (size_t)256 * 1024 * 2, (size_t)256 * 1024 * 2); EpiOut E{ldarg(0), out, MOD, RST, H2, ldarg(24), (unsigned*)SSQ2, (unsigned*)(ws + WS_BAR) + 4096 + 64 * 256, lds + 131072}; pg8::gemm_phase(lds, g, S, E); }
    xcd_barrier(xbar);

    }
#endif
#if PHM & 64
    { PHASE_IDS
    REP(64) {
        pg8::Gemm g{H2, WT_up, 1024, 1024}; pg8::StaticOrder S; S.init(256, 22, G, bx, (size_t)256 * 1024 * 2, (size_t)256 * 1024 * 2);
        EpiUp E{ACT, HALO, FIX, ldarg(26), ldarg(27)};
        pg8::gemm_phase(lds, g, S, E);
    }
    xcd_barrier(xbar);

    }
#endif
#if PHM & 128
    { PHASE_IDS
    for (int pm = bx; pm < 256; pm += G) {
        const float* conv_w = ldarg(26); const float* conv_b = ldarg(27);
        for (int it = tid; it < 4 * DFF; it += 512) {
            const int col = it % DFF, sj = it / DFF, wr = sj >> 1, jj = sj & 1;
            const float* f = FIX + ((size_t)(pm * 2 + wr) * 4) * DFF + col;
            const float g0 = f[0], v0 = f[DFF], g1 = f[2 * DFF], v1 = f[3 * DFF];
            float h6 = 0.f, h7 = 0.f;
            if (wr == 1) { const float* hp = HALO + ((size_t)(pm * 2) * 2) * DFF + col; h6 = hp[0]; h7 = hp[DFF]; }
            else if ((pm & 31) != 0) { const float* hp = HALO + ((size_t)((pm - 1) * 2 + 1) * 2) * DFF + col; h6 = hp[0]; h7 = hp[DFF]; }
            const float w0 = conv_w[col], w1 = conv_w[DFF + col], w2 = conv_w[2 * DFF + col], bb = conv_b[col];
            const float y = jj == 0 ? gelu_t(bb + w0 * h6 + w1 * h7 + w2 * g0) * v0 : gelu_t(bb + w0 * h7 + w1 * g0 + w2 * g1) * v1;
            ACT[((size_t)pm * 256 + 128 * wr + jj) * DFF + col] = (bf16_t)(pk2(y, 0.f) & 0xffffu);
        }
    }
    xcd_barrier(xbar);
    { pg8::Gemm g{ACT, WT_down, DFF, DFF}; pg8::StaticOrder S; S.init(256, 4, G, bx, (size_t)256 * DFF * 2, (size_t)256 * DFF * 2);
      EpiDownNorm E{out, out, MOD + 5120, ldarg(29), (unsigned*)ASSQ, (unsigned*)(ws + WS_BAR) + 4096, lds + 131072}; pg8::gemm_phase(lds, g, S, E); }
    }
#endif
}

extern "C" void kernel_launch(void* const* d_in, const int* in_sizes, int n_in, void* d_out, int out_size, void* d_ws, size_t ws_size, hipStream_t stream) {
    constexpr int LDSB = 147456;
    static int grid = 0;
    if (!grid) {
        if (n_in != 30 || out_size != NT * DM || ws_size < WS_END) { fprintf(stderr, "kernel_launch: unexpected problem (n_in %d out %d ws %zu need %zu)\n", n_in, out_size, ws_size, (size_t)WS_END); grid = -1; return; }
        int dev = 0, cus = 0, per = 0;
        (void)hipGetDevice(&dev);
        (void)hipDeviceGetAttribute(&cus, hipDeviceAttributeMultiprocessorCount, dev);
        (void)hipFuncSetAttribute((const void*)fwd_kernel, hipFuncAttributeMaxDynamicSharedMemorySize, LDSB);
        (void)hipOccupancyMaxActiveBlocksPerMultiprocessor(&per, (const void*)fwd_kernel, 512, LDSB);
        if (per < 1) per = 1;
        grid = cus * per; if (grid > 256) grid = 256;
    }
    if (grid < 0) return;
    (void)hipMemsetAsync((char*)d_ws + WS_BAR, 0, (4096 + 2 * 64 * 256) * 4, stream);
    Args a{};
    for (int i = 0; i < 30; ++i) a.in[i] = d_in[i];
    a.out = (float*)d_out; a.ws = (unsigned char*)d_ws;
    void* args[] = {&a};
    hipError_t e = hipLaunchCooperativeKernel((const void*)fwd_kernel, dim3(grid), dim3(512), args, LDSB, stream);
    if (e != hipSuccess) fprintf(stderr, "cooperative launch failed: %s (grid %d)\n", hipGetErrorString(e), grid);
}
```
